# Optimizing an MI355X kernel written in HIP

```python
import math
import jax, jax.numpy as jnp
from jax import lax
import numpy as np

D_MODEL = 2048
BATCH = 4
SEQ = 2048
DEPTH = 1
DEC_BATCH = 16
DEC_SEQ = 32
PAST_LEN = 2048

CHUNK = 64
HEAD_DIM = 128
N_HEADS_GDN = 8
N_HEADS_SB = 8
GDN_WIDTH = N_HEADS_GDN * HEAD_DIM
SB_WIDTH = N_HEADS_SB * HEAD_DIM
MIX_WIDTH = GDN_WIDTH + SB_WIDTH
CONV_W = 4
D_FF = 4 * D_MODEL
SB_BLOCK = 128
DEEPNORM_ALPHA = (2 * DEPTH) ** 0.25
DEEPNORM_BETA = (8 * DEPTH) ** -0.25
LN_EPS = 1e-5
RMS_EPS = 1e-6
L2_EPS = 1e-6

OFF_GDN_Z = 3 * GDN_WIDTH
OFF_GDN_B = 4 * GDN_WIDTH
OFF_GDN_A = OFF_GDN_B + N_HEADS_GDN
OFF_SB = OFF_GDN_A + N_HEADS_GDN
PROJ_WIDTH = OFF_SB + 3 * SB_WIDTH

kernel_name = "hybrid_gdn_stickbreaking_stream_step"


def layer_norm(x, g, b):
    xf = x.astype(jnp.float32)
    mu = jnp.mean(xf, axis=-1, keepdims=True)
    var = jnp.mean(jnp.square(xf - mu), axis=-1, keepdims=True)
    y = (xf - mu) * lax.rsqrt(var + LN_EPS) * g.astype(jnp.float32) + b.astype(jnp.float32)
    return y.astype(x.dtype)


def l2_normalize(t):
    return t * lax.rsqrt(jnp.sum(jnp.square(t), axis=-1, keepdims=True) + L2_EPS)


def causal_short_conv(u, buf, w):
    T = u.shape[1]
    up = jnp.concatenate([buf.astype(u.dtype), u], axis=1)
    out = up[:, 0:T] * w[0]
    for i in range(1, CONV_W):
        out = out + up[:, i:i + T] * w[i]
    return jax.nn.silu(out), up[:, T:]


def gated_delta_rule(q, k, v, beta, g, S0):
    B, T, H, dk = q.shape
    dv = v.shape[-1]
    C = CHUNK if T % CHUNK == 0 else T
    N = T // C

    def blocks(t):
        t = t.reshape((B, N, C, H) + t.shape[3:])
        return jnp.moveaxis(t, 3, 1)

    q, k, v, beta, g = blocks(q), blocks(k), blocks(v), blocks(beta), blocks(g)
    g_cum = jnp.cumsum(g, axis=-1)
    idx = jnp.arange(C)
    incl = idx[:, None] >= idx[None, :]
    strict = idx[:, None] > idx[None, :]
    decay = jnp.exp(jnp.where(incl, g_cum[..., :, None] - g_cum[..., None, :], -jnp.inf))
    k_beta = k * beta[..., None]
    m = jnp.where(strict, jnp.einsum('bhnid,bhnjd->bhnij', k_beta, k) * decay, 0.0)
    eye = jnp.eye(C, dtype=m.dtype)
    t_inv = lax.linalg.triangular_solve(eye + m, jnp.broadcast_to(eye, m.shape),
                                        left_side=True, lower=True, unit_diagonal=True)
    u = jnp.einsum('bhnij,bhnjd->bhnid', t_inv, v * beta[..., None])
    w = jnp.einsum('bhnij,bhnjd->bhnid', t_inv, k_beta * jnp.exp(g_cum)[..., None])
    attn = jnp.einsum('bhnid,bhnjd->bhnij', q, k) * decay
    q_dec = q * jnp.exp(g_cum)[..., None]
    k_tail = k * jnp.exp(g_cum[..., -1:] - g_cum)[..., None]
    g_tot = jnp.exp(g_cum[..., -1])
    xs = tuple(jnp.moveaxis(t, 2, 0) for t in (u, w, q_dec, attn, k_tail, g_tot))

    def step(S, inp):
        u_n, w_n, qd_n, at_n, kt_n, gt_n = inp
        v_new = u_n - jnp.einsum('bhcd,bhde->bhce', w_n, S)
        o = jnp.einsum('bhcd,bhde->bhce', qd_n, S) + jnp.einsum('bhij,bhje->bhie', at_n, v_new)
        S = S * gt_n[..., None, None] + jnp.einsum('bhcd,bhce->bhde', kt_n, v_new)
        return S, o

    S_fin, o = lax.scan(step, S0, xs)
    o = jnp.transpose(o, (1, 0, 3, 2, 4)).reshape(B, T, H, dv)
    return o, S_fin


def stick_breaking(q, k, v, q_pos, k_pos):
    z = jnp.einsum('bqhd,bkhd->bhqk', q.astype(jnp.float32), k.astype(jnp.float32)) * (HEAD_DIM ** -0.5)
    causal = k_pos[None, :] < q_pos[:, None]
    log_1m = jnp.where(causal, jax.nn.log_sigmoid(-z), 0.0)
    rest = lax.cumsum(log_1m, axis=3, reverse=True) - log_1m
    wts = jnp.where(causal, jnp.exp(jax.nn.log_sigmoid(z) + rest), 0.0)
    return jnp.einsum('bhqk,bkhd->bqhd', wts, v.astype(jnp.float32))


def stick_breaking_prompt(q, k, v):
    B, T, H, d = q.shape
    nb = T // SB_BLOCK
    pos = jnp.arange(T)
    qb = jnp.moveaxis(q.reshape(B, nb, SB_BLOCK, H, d), 1, 0)
    qpos = pos.reshape(nb, SB_BLOCK)
    out = lax.map(lambda blk: stick_breaking(blk[0], k, v, blk[1], pos), (qb, qpos))
    return jnp.moveaxis(out, 0, 1).reshape(B, T, H, d)


def hybrid_layer(x, conv_buf, S0, k_past, v_past, w_in, conv_w, a_log, dt_bias, gdn_norm_w,
                 w_out, ln1_g, ln1_b, w_up, w_down, ln2_g, ln2_b):
    B, T, _ = x.shape
    proj = x @ w_in
    qkv, conv_new = causal_short_conv(proj[..., :OFF_GDN_Z], conv_buf, conv_w)
    qkv = qkv.astype(jnp.float32).reshape(B, T, 3, N_HEADS_GDN, HEAD_DIM)
    q_a = l2_normalize(qkv[:, :, 0]) * (HEAD_DIM ** -0.5)
    k_a = l2_normalize(qkv[:, :, 1])
    v_a = qkv[:, :, 2]
    z = proj[..., OFF_GDN_Z:OFF_GDN_B].astype(jnp.float32).reshape(B, T, N_HEADS_GDN, HEAD_DIM)
    beta = jax.nn.sigmoid(proj[..., OFF_GDN_B:OFF_GDN_A].astype(jnp.float32))
    g = -jnp.exp(a_log.astype(jnp.float32)) * jax.nn.softplus(
        proj[..., OFF_GDN_A:OFF_SB].astype(jnp.float32) + dt_bias.astype(jnp.float32))
    o_a, S_new = gated_delta_rule(q_a, k_a, v_a, beta, g, S0.astype(jnp.float32))
    o_a = (o_a * lax.rsqrt(jnp.mean(jnp.square(o_a), axis=-1, keepdims=True) + RMS_EPS)
           * gdn_norm_w.astype(jnp.float32) * jax.nn.silu(z))
    sb = proj[..., OFF_SB:].reshape(B, T, 3, N_HEADS_SB, HEAD_DIM)
    q_b, k_b, v_b = sb[:, :, 0], sb[:, :, 1], sb[:, :, 2]
    if k_past is None:
        o_b = stick_breaking_prompt(q_b, k_b, v_b)
    else:
        P = k_past.shape[1]
        k_all = jnp.concatenate([k_past.astype(k_b.dtype), k_b], axis=1)
        v_all = jnp.concatenate([v_past.astype(v_b.dtype), v_b], axis=1)
        o_b = stick_breaking(q_b, k_all, v_all, P + jnp.arange(T), jnp.arange(P + T))
    mixed = jnp.concatenate([o_a.reshape(B, T, GDN_WIDTH), o_b.reshape(B, T, SB_WIDTH)],
                            axis=-1).astype(x.dtype)
    x = layer_norm(DEEPNORM_ALPHA * x + mixed @ w_out, ln1_g, ln1_b)
    h = jnp.square(jax.nn.relu(x @ w_up))
    x = layer_norm(DEEPNORM_ALPHA * x + h @ w_down, ln2_g, ln2_b)
    return x, conv_new, S_new, k_b, v_b


def setup_inputs(seed: int = 0) -> dict:
    key = jax.random.key(seed)
    ks = jax.random.split(key, 18)
    f32 = jnp.float32
    col_scale = jnp.ones((PROJ_WIDTH,), f32)
    col_scale = col_scale.at[2 * GDN_WIDTH:3 * GDN_WIDTH].set(DEEPNORM_BETA)
    col_scale = col_scale.at[OFF_SB + 2 * SB_WIDTH:].set(DEEPNORM_BETA)
    w_in = jax.random.normal(ks[6], (DEPTH, D_MODEL, PROJ_WIDTH), f32) * (D_MODEL ** -0.5) * col_scale
    log_lo, log_hi = math.log(1e-3), math.log(1e-1)
    dt = jnp.exp(jax.random.uniform(ks[9], (DEPTH, N_HEADS_GDN), f32) * (log_hi - log_lo) + log_lo)
    dt_bias = dt + jnp.log(-jnp.expm1(-dt))
    return {
        "x_prompt": jax.random.normal(ks[0], (BATCH, SEQ, D_MODEL), f32),
        "x_sample": jax.random.normal(ks[1], (DEC_BATCH, DEC_SEQ, D_MODEL), f32),
        "state_gdn_conv": jax.random.normal(ks[2], (DEPTH, DEC_BATCH, CONV_W - 1, 3 * GDN_WIDTH), f32),
        "state_gdn_S": 0.5 * jax.random.normal(ks[3], (DEPTH, DEC_BATCH, N_HEADS_GDN, HEAD_DIM, HEAD_DIM), f32),
        "cache_sb_k": jax.random.normal(ks[4], (DEPTH, DEC_BATCH, PAST_LEN, N_HEADS_SB, HEAD_DIM), f32),
        "cache_sb_v": DEEPNORM_BETA * jax.random.normal(ks[5], (DEPTH, DEC_BATCH, PAST_LEN, N_HEADS_SB, HEAD_DIM), f32),
        "w_in": w_in,
        "conv_w": 0.5 * jax.random.normal(ks[7], (DEPTH, CONV_W, 3 * GDN_WIDTH), f32),
        "a_log": jnp.log(jax.random.uniform(ks[8], (DEPTH, N_HEADS_GDN), f32, 1.0, 16.0)),
        "dt_bias": dt_bias,
        "gdn_norm_w": 1.0 + 0.02 * jax.random.normal(ks[10], (DEPTH, HEAD_DIM), f32),
        "w_out": jax.random.normal(ks[11], (DEPTH, MIX_WIDTH, D_MODEL), f32) * (MIX_WIDTH ** -0.5) * DEEPNORM_BETA,
        "ln1_g": 1.0 + 0.02 * jax.random.normal(ks[12], (DEPTH, D_MODEL), f32),
        "ln1_b": 0.02 * jax.random.normal(ks[13], (DEPTH, D_MODEL), f32),
        "w_up": jax.random.normal(ks[14], (DEPTH, D_MODEL, D_FF), f32) * (D_MODEL ** -0.5),
        "w_down": jax.random.normal(ks[15], (DEPTH, D_FF, D_MODEL), f32) * (D_FF ** -0.5) * DEEPNORM_BETA,
        "ln2_g": 1.0 + 0.02 * jax.random.normal(ks[16], (DEPTH, D_MODEL), f32),
        "ln2_b": 0.02 * jax.random.normal(ks[17], (DEPTH, D_MODEL), f32),
    }


def reference(x_prompt, x_sample, state_gdn_conv, state_gdn_S, cache_sb_k, cache_sb_v,
              w_in, conv_w, a_log, dt_bias, gdn_norm_w, w_out, ln1_g, ln1_b,
              w_up, w_down, ln2_g, ln2_b):
    yp, ys = x_prompt, x_sample
    conv_p, S_p, k_p, v_p = [], [], [], []
    conv_s, S_s, k_s, v_s = [], [], [], []
    for l in range(DEPTH):
        wl = (w_in[l], conv_w[l], a_log[l], dt_bias[l], gdn_norm_w[l], w_out[l],
              ln1_g[l], ln1_b[l], w_up[l], w_down[l], ln2_g[l], ln2_b[l])
        b_p = yp.shape[0]
        zero_conv = jnp.zeros((b_p, CONV_W - 1, 3 * GDN_WIDTH), yp.dtype)
        zero_S = jnp.zeros((b_p, N_HEADS_GDN, HEAD_DIM, HEAD_DIM), jnp.float32)
        yp, c1, s1, kk1, vv1 = hybrid_layer(yp, zero_conv, zero_S, None, None, *wl)
        ys, c2, s2, kk2, vv2 = hybrid_layer(ys, state_gdn_conv[l], state_gdn_S[l],
                                            cache_sb_k[l], cache_sb_v[l], *wl)
        conv_p.append(c1); S_p.append(s1); k_p.append(kk1); v_p.append(vv1)
        conv_s.append(c2); S_s.append(s2); k_s.append(kk2); v_s.append(vv2)
    new_conv_p = jnp.stack(conv_p)
    new_S_p = jnp.stack(S_p)
    new_k_p = jnp.stack(k_p)
    new_v_p = jnp.stack(v_p)
    new_conv_s = jnp.stack(conv_s)
    new_S_s = jnp.stack(S_s)
    new_k_s = jnp.stack(k_s)
    new_v_s = jnp.stack(v_s)
    return (yp, ys, new_conv_p, new_S_p, new_k_p, new_v_p, new_conv_s, new_S_s, new_k_s, new_v_s)
```

```cpp
#include <hip/hip_runtime.h>
#include <hip/hip_cooperative_groups.h>
#include <cstdio>
#include <cstdint>
namespace cg = cooperative_groups;

#ifndef MK_N_LAUNCHES
#define MK_N_LAUNCHES 1
#endif

namespace pg8 {
#define PG8_LAS __attribute__((address_space(3)))
typedef unsigned short bf16_t;
typedef short bf16x8 __attribute__((ext_vector_type(8)));
typedef float f32x4 __attribute__((ext_vector_type(4)));
typedef unsigned u32x4 __attribute__((ext_vector_type(4)));
constexpr int BM = 256, BK = 64, HALF = 128, HTB = HALF * BK * 2  , STAGE_BYTES = 8 * HTB, NXCD = 8, WGM = 8;

__host__ __device__ __forceinline__ int lds_byte(int r, int c) { const int st = (r >> 4) * 2 + (c >> 5), rr = r & 15, cc = c & 31, ob = rr * 64 + cc * 2; return st * 1024 + (ob ^ (((ob >> 9) & 1) << 5)); }
__host__ __device__ __forceinline__ void stage_rc(int b, int& R, int& C) { const int st = b / 1024, sb = b % 1024, swz = sb ^ (((sb >> 9) & 1) << 5); R = (st >> 1) * 16 + swz / 64; C = (st & 1) * 32 + (swz % 64) / 2; }
__host__ __device__ __forceinline__ int perm32(int rho) { const int n = rho >> 4, i = rho & 15; return 8 * (i >> 2) + 4 * n + (i & 3); }

struct Unit { int pm, pn, k0, nt, split; };
struct Gemm { const bf16_t* A; const bf16_t* Bt; int M, N, K; };

struct StaticOrder {
    int nM, nN, nwg, G, c, ntk;
    __host__ __device__ void init(int M, int N, int G_, int c_, int K) { nM = M / BM; nN = N / BM; nwg = nM * nN; G = G_; c = c_; ntk = K / BK; }
    __host__ __device__ bool next(int i, Unit& u) const {
        const long L = (long)i * G + c; if (L >= nwg) return false;
        int wgid = (int)L; { const int q = nwg / NXCD, r = nwg % NXCD, xcd = wgid % NXCD, off = wgid / NXCD; wgid = (xcd < r ? xcd * (q + 1) : r * (q + 1) + (xcd - r) * q) + off; }
        const int nig = WGM * nN, gid = wgid / nig, fm = gid * WGM, gsz = (nM - fm) < WGM ? (nM - fm) : WGM;
        u.pm = fm + ((wgid % nig) % gsz); u.pn = (wgid % nig) / gsz; u.k0 = 0; u.nt = ntk; u.split = -1; return true;
    }
    __device__ __forceinline__ void a_ready(const Unit&) const {}
    __device__ __forceinline__ void done(const Unit&) const {}
};
struct SplitOrder {
    StaticOrder S; int nmain, nN, nMm, nsplit, ntk, G, c, ntail;
    __host__ __device__ void init(int Mmain, int Mtot, int N, int K, int nsplit_, int G_, int c_) {
        S.init(Mmain, N, G_, c_, K); G = G_; c = c_; nN = N / BM; nMm = Mmain / BM; nsplit = nsplit_; ntk = K / BK / nsplit_;
        nmain = (S.nwg > c_) ? (S.nwg - c_ + G_ - 1) / G_ : 0;
        ntail = (Mtot - Mmain) / BM * nN * nsplit_;
    }
    __host__ __device__ bool next(int i, Unit& u) const {
        if (i < nmain) return S.next(i, u);
        const long sub = (long)(i - nmain) * G + c; if (sub >= ntail) return false;
        const int tile = (int)sub / nsplit, ks = (int)sub % nsplit;
        u.pm = nMm + tile / nN; u.pn = tile % nN; u.k0 = ks * ntk; u.nt = ntk; u.split = ks; return true;
    }
    __device__ __forceinline__ void a_ready(const Unit&) const {}
    __device__ __forceinline__ void done(const Unit&) const {}
};

__device__ __forceinline__ unsigned cvt_pk_bf16(float lo, float hi) { unsigned r; asm volatile("v_cvt_pk_bf16_f32 %0, %1, %2" : "=v"(r) : "v"(lo), "v"(hi)); return r; }
typedef float f32x2 __attribute__((ext_vector_type(2)));
typedef unsigned u32x2 __attribute__((ext_vector_type(2)));
struct EpiProj {
    static constexpr bool PERM = true, AFTER_DRAIN = false;
    bf16_t* O; float* outp;
    size_t off_convp, off_kp, off_vp, off_convs, off_ks, off_vs;
    __device__ __forceinline__ void operator()(const f32x4 (&acc)[2][2][4][2], const Unit& u, int wr, int wc, int fr, int fq) const {
        const int row0 = u.pm * BM + wr * 64 + fr; const int colt = u.pn * BM; const int col0 = colt + wc * 32 + 8 * fq;
        const bool is_k = (colt >= 5120 && colt < 6144), is_v = (colt >= 6144), is_conv = (colt < 3072), samp = (u.pm >= 32);
#pragma unroll
        for (int ai = 0; ai < 2; ++ai)
#pragma unroll
            for (int m = 0; m < 4; ++m) {
                const int row = row0 + ai * HALF + m * 16;
                bf16_t* rowp = O + (size_t)row * 7168 + col0;
#pragma unroll
                for (int bj = 0; bj < 2; ++bj) {
                    const f32x4 v0 = acc[ai][bj][m][0], v1 = acc[ai][bj][m][1];
                    u32x4 w; w.x = cvt_pk_bf16(v0[0], v0[1]); w.y = cvt_pk_bf16(v0[2], v0[3]); w.z = cvt_pk_bf16(v1[0], v1[1]); w.w = cvt_pk_bf16(v1[2], v1[3]);
                    *(u32x4*)(rowp + bj * HALF) = w;
                    const int col = col0 + bj * HALF;
                    if (is_k || is_v) {
                        float* dst = outp + (samp ? (is_k ? off_ks : off_vs) + (size_t)(row - 8192) * 1024 : (is_k ? off_kp : off_vp) + (size_t)row * 1024) + (col - (is_k ? 5120 : 6144));
                        *(f32x4*)dst = v0; *(f32x4*)(dst + 4) = v1;
                    }
                    if (is_conv) {
                        if (!samp) { const int t = row & 2047; if (t >= 2045) { float* dst = outp + off_convp + (size_t)((row >> 11) * 3 + (t - 2045)) * 3072 + col; *(f32x4*)dst = v0; *(f32x4*)(dst + 4) = v1; } }
                        else { const int rs = row - 8192, t = rs & 31; if (t >= 29) { float* dst = outp + off_convs + (size_t)((rs >> 5) * 3 + (t - 29)) * 3072 + col; *(f32x4*)dst = v0; *(f32x4*)(dst + 4) = v1; } }
                    }
                }
            }
    }
};
struct EpiUp {
    static constexpr bool PERM = true, AFTER_DRAIN = false;
    bf16_t* O; int ldc;
    __device__ __forceinline__ void operator()(const f32x4 (&acc)[2][2][4][2], const Unit& u, int wr, int wc, int fr, int fq) const {
        const int row0 = u.pm * BM + wr * 64 + fr; const int col0 = u.pn * BM + wc * 32 + 8 * fq;
#pragma unroll
        for (int ai = 0; ai < 2; ++ai)
#pragma unroll
            for (int m = 0; m < 4; ++m) {
                bf16_t* rowp = O + (size_t)(row0 + ai * HALF + m * 16) * ldc + col0;
#pragma unroll
                for (int bj = 0; bj < 2; ++bj) {
                    f32x4 v0 = acc[ai][bj][m][0], v1 = acc[ai][bj][m][1];
#pragma unroll
                    for (int e = 0; e < 4; ++e) { const float a = fmaxf(v0[e], 0.f), b = fmaxf(v1[e], 0.f); v0[e] = a * a; v1[e] = b * b; }
                    u32x4 w; w.x = cvt_pk_bf16(v0[0], v0[1]); w.y = cvt_pk_bf16(v0[2], v0[3]); w.z = cvt_pk_bf16(v1[0], v1[1]); w.w = cvt_pk_bf16(v1[2], v1[3]);
                    *(u32x4*)(rowp + bj * HALF) = w;
                }
            }
    }
};
template <bool RB> struct EpiRes {
    static constexpr bool PERM = false, AFTER_DRAIN = false;
    const void* res0; const void* res1; int split; float* out; int ldc; float alpha; float* part;
    __device__ __forceinline__ void operator()(const f32x4 (&acc)[2][2][4][2], const Unit& u, int wr, int wc, int fr, int fq) const {
        const int col0 = u.pn * BM + wc * 32 + 4 * fq;
        if (u.split >= 0) {
#pragma unroll
            for (int ai = 0; ai < 2; ++ai)
#pragma unroll
                for (int m = 0; m < 4; ++m) {
                    const int row = u.pm * BM + ai * HALF + wr * 64 + m * 16 + fr;
                    float* op = part + ((size_t)u.split * 512 + (row - 8192)) * ldc + col0;
#pragma unroll
                    for (int bj = 0; bj < 2; ++bj)
#pragma unroll
                        for (int n = 0; n < 2; ++n) *(f32x4*)(op + bj * HALF + n * 16) = acc[ai][bj][m][n];
                }
            return;
        }
        if (RB) {
            u32x2 w[2][4][2][2];
#pragma unroll
            for (int ai = 0; ai < 2; ++ai)
#pragma unroll
                for (int m = 0; m < 4; ++m) {
                    const int row = u.pm * BM + ai * HALF + wr * 64 + m * 16 + fr;
                    const bf16_t* rp = (const bf16_t*)(row < split ? res0 : res1) + (row < split ? (size_t)row : (size_t)(row - split)) * ldc + col0;
#pragma unroll
                    for (int bj = 0; bj < 2; ++bj)
#pragma unroll
                        for (int n = 0; n < 2; ++n) w[ai][m][bj][n] = *(const u32x2*)(rp + bj * HALF + n * 16);
                }
#pragma unroll
            for (int ai = 0; ai < 2; ++ai)
#pragma unroll
                for (int m = 0; m < 4; ++m) {
                    const int row = u.pm * BM + ai * HALF + wr * 64 + m * 16 + fr;
                    float* op = out + (size_t)row * ldc + col0;
#pragma unroll
                    for (int bj = 0; bj < 2; ++bj)
#pragma unroll
                        for (int n = 0; n < 2; ++n) {
                            const unsigned wx = w[ai][m][bj][n].x, wy = w[ai][m][bj][n].y; f32x4 r;
                            r[0] = __builtin_bit_cast(float, wx << 16); r[1] = __builtin_bit_cast(float, wx & 0xffff0000u); r[2] = __builtin_bit_cast(float, wy << 16); r[3] = __builtin_bit_cast(float, wy & 0xffff0000u);
                            *(f32x4*)(op + bj * HALF + n * 16) = r * alpha + acc[ai][bj][m][n];
                        }
                }
            return;
        }
#pragma unroll
        for (int ai = 0; ai < 2; ++ai) {
            f32x4 r[4][2][2];
#pragma unroll
            for (int m = 0; m < 4; ++m) {
                const int row = u.pm * BM + ai * HALF + wr * 64 + m * 16 + fr;
                const size_t roff = (row < split ? (size_t)row : (size_t)(row - split)) * ldc + col0;
                const void* rb = row < split ? res0 : res1;
#pragma unroll
                for (int bj = 0; bj < 2; ++bj)
#pragma unroll
                    for (int n = 0; n < 2; ++n) {
                        if (RB) { const u32x2 w = *(const u32x2*)((const bf16_t*)rb + roff + bj * HALF + n * 16); const unsigned wx = w.x, wy = w.y;
                                  r[m][bj][n][0] = __builtin_bit_cast(float, wx << 16); r[m][bj][n][1] = __builtin_bit_cast(float, wx & 0xffff0000u); r[m][bj][n][2] = __builtin_bit_cast(float, wy << 16); r[m][bj][n][3] = __builtin_bit_cast(float, wy & 0xffff0000u); }
                        else r[m][bj][n] = *(const f32x4*)((const float*)rb + roff + bj * HALF + n * 16);
                    }
            }
#pragma unroll
            for (int m = 0; m < 4; ++m) {
                const int row = u.pm * BM + ai * HALF + wr * 64 + m * 16 + fr;
                float* op = out + (size_t)row * ldc + col0;
#pragma unroll
                for (int bj = 0; bj < 2; ++bj)
#pragma unroll
                    for (int n = 0; n < 2; ++n) *(f32x4*)(op + bj * HALF + n * 16) = r[m][bj][n] * alpha + acc[ai][bj][m][n];
            }
        }
    }
};

template <class Epi, class Sched, bool ALIGN_EPI = false, bool SP2 = false>
__device__ __forceinline__ void gemm_phase(PG8_LAS unsigned char* lds, const Gemm g, const Sched& S, const Epi& E) {
    const int tid = threadIdx.x, wid = __builtin_amdgcn_readfirstlane(tid >> 6), lane = tid & 63, wr = wid >> 2, wc = wid & 3, fr = lane & 15, fq = lane >> 4;
    const int K = g.K;
    unsigned voffA[2], voffB[2];
#pragma unroll
    for (int i = 0; i < 2; ++i) { int R, C; stage_rc(tid * 16 + i * 8192, R, C); const int Rb = Epi::PERM ? ((R & ~31) + perm32(R & 31)) : R;
        voffA[i] = (unsigned)(R * K + C) * 2u; voffB[i] = (unsigned)(Rb * K + C) * 2u; }
    const size_t kstep = (size_t)(BK * 2);
    const size_t hstep = (size_t)HALF * K * 2;
    const size_t tstep = 2 * hstep;
    const unsigned ldsw = (unsigned)wid * 1024u;
    const int aoff = lds_byte(wr * 64 + fr, fq * 8), boff = lds_byte(wc * 32 + fr, fq * 8);
#define PG8_SA(b, h) (((b) * 2 + (h)) * HTB)
#define PG8_SB(b, h) ((4 + (b) * 2 + (h)) * HTB)
#define PG8_STAGE(bufoff, gbase, voff) do { _Pragma("unroll") for (int _i = 0; _i < 2; ++_i) \
        __builtin_amdgcn_global_load_lds((const unsigned*)((const char*)(gbase) + (voff)[_i]), (PG8_LAS unsigned*)(lds + (bufoff) + ldsw + _i * 8192), 16, 0, 0); } while (0)
#define PG8_LDA(dst, b, h) do { _Pragma("unroll") for (int m = 0; m < 4; ++m) _Pragma("unroll") for (int k = 0; k < 2; ++k) dst[m][k] = *(const PG8_LAS bf16x8*)(lds + PG8_SA(b, h) + aoff + m * 2048 + k * 1024); } while (0)
#define PG8_LDB(dst, b, h) do { _Pragma("unroll") for (int n = 0; n < 2; ++n) _Pragma("unroll") for (int k = 0; k < 2; ++k) dst[n][k] = *(const PG8_LAS bf16x8*)(lds + PG8_SB(b, h) + boff + n * 2048 + k * 1024); } while (0)
#define PG8_MMA(ai, bj, At, Bt) do { __builtin_amdgcn_s_setprio(1); _Pragma("unroll") for (int m = 0; m < 4; ++m) _Pragma("unroll") for (int n = 0; n < 2; ++n) _Pragma("unroll") for (int k = 0; k < 2; ++k) \
        acc[ai][bj][m][n] = __builtin_amdgcn_mfma_f32_16x16x32_bf16(Bt[n][k], At[m][k], acc[ai][bj][m][n], 0, 0, 0); __builtin_amdgcn_s_setprio(0); } while (0)
#define PG8_WAIT_V(n) asm volatile("s_waitcnt vmcnt(" #n ")" ::: "memory")
#define PG8_WAIT_L(n) asm volatile("s_waitcnt lgkmcnt(" #n ")" ::: "memory")
#define PG8_BAR __builtin_amdgcn_s_barrier()
#define PG8_SCHED __builtin_amdgcn_sched_barrier(0)
    Unit cur, nxt; int ui = 0;
    if (!S.next(0, cur)) return;
    f32x4 acc[2][2][4][2];
#pragma unroll
    for (int a = 0; a < 2; ++a)
#pragma unroll
        for (int b = 0; b < 2; ++b)
#pragma unroll
            for (int m = 0; m < 4; ++m)
#pragma unroll
                for (int n = 0; n < 2; ++n) acc[a][b][m][n] = (f32x4){0.f, 0.f, 0.f, 0.f};
    bf16x8 At[4][2], B0[2][2], B1[2][2];
    const char* cA = (const char*)g.A + (size_t)cur.pm * tstep + (size_t)cur.k0 * kstep; const char* cB = (const char*)g.Bt + (size_t)cur.pn * tstep + (size_t)cur.k0 * kstep;
    S.a_ready(cur);
    if constexpr (SP2) {
        PG8_STAGE(PG8_SB(0, 0), cB, voffB); PG8_STAGE(PG8_SB(0, 1), cB + hstep, voffB); PG8_STAGE(PG8_SA(0, 0), cA, voffA); PG8_STAGE(PG8_SA(0, 1), cA + hstep, voffA);
        if (wr == 1) PG8_BAR;
        PG8_WAIT_V(2); PG8_BAR;
        PG8_STAGE(PG8_SB(1, 0), cB + kstep, voffB); PG8_STAGE(PG8_SA(1, 0), cA + kstep, voffA); PG8_STAGE(PG8_SB(1, 1), cB + hstep + kstep, voffB);
        PG8_WAIT_V(6); PG8_BAR;
    } else {
        PG8_STAGE(PG8_SB(0, 0), cB, voffB); PG8_STAGE(PG8_SA(0, 0), cA, voffA); PG8_STAGE(PG8_SB(0, 1), cB + hstep, voffB); PG8_STAGE(PG8_SA(0, 1), cA + hstep, voffA);
        if (wr == 1) PG8_BAR;
        PG8_WAIT_V(4); PG8_BAR;
        PG8_STAGE(PG8_SB(1, 0), cB + kstep, voffB); PG8_STAGE(PG8_SA(1, 0), cA + kstep, voffA); PG8_STAGE(PG8_SB(1, 1), cB + hstep + kstep, voffB);
        PG8_WAIT_V(6); PG8_BAR;
    }
    for (;;) {
        const bool has_next = S.next(ui + 1, nxt);
        const char* nA = has_next ? (const char*)g.A + (size_t)nxt.pm * tstep + (size_t)nxt.k0 * kstep : cA; const char* nB = has_next ? (const char*)g.Bt + (size_t)nxt.pn * tstep + (size_t)nxt.k0 * kstep : cB;
        const int nt = cur.nt;
        for (int t = 0; t < nt; t += 2) {
            const bool last = (t == nt - 2);
            const char* a1 = cA + (size_t)(t + 1) * kstep;
            const char* a2 = last ? nA : cA + (size_t)(t + 2) * kstep; const char* b2 = last ? nB : cB + (size_t)(t + 2) * kstep;
            const char* a3 = a2 + kstep; const char* b3 = b2 + kstep;
            if (last && has_next) S.a_ready(nxt);
            if constexpr (SP2) {
            PG8_LDB(B0, 0, 0); PG8_LDB(B1, 0, 1); PG8_SCHED; PG8_LDA(At, 0, 0); PG8_STAGE(PG8_SA(1, 1), a1 + hstep, voffA);
            PG8_WAIT_V(8); PG8_WAIT_L(0); PG8_BAR; PG8_MMA(0, 0, At, B0); PG8_MMA(0, 1, At, B1); PG8_BAR; PG8_SCHED;
            PG8_LDA(At, 0, 1); PG8_STAGE(PG8_SB(0, 0), b2, voffB); PG8_STAGE(PG8_SB(0, 1), b2 + hstep, voffB); PG8_STAGE(PG8_SA(0, 0), a2, voffA);
            PG8_WAIT_V(8); PG8_WAIT_L(0); PG8_BAR; PG8_MMA(1, 0, At, B0); PG8_MMA(1, 1, At, B1); PG8_BAR; PG8_SCHED;
            PG8_LDB(B0, 1, 0); PG8_LDB(B1, 1, 1); PG8_SCHED; PG8_LDA(At, 1, 0); PG8_STAGE(PG8_SA(0, 1), a2 + hstep, voffA);
            PG8_WAIT_V(8); PG8_WAIT_L(0); PG8_BAR; PG8_MMA(0, 0, At, B0); PG8_MMA(0, 1, At, B1); PG8_BAR; PG8_SCHED;
            PG8_LDA(At, 1, 1); PG8_STAGE(PG8_SB(1, 0), b3, voffB); PG8_STAGE(PG8_SB(1, 1), b3 + hstep, voffB); PG8_STAGE(PG8_SA(1, 0), a3, voffA);
            PG8_WAIT_V(8); PG8_WAIT_L(0); PG8_BAR; PG8_MMA(1, 0, At, B0); PG8_MMA(1, 1, At, B1); PG8_BAR; PG8_SCHED;
            } else {
            PG8_LDB(B0, 0, 0); PG8_SCHED; PG8_LDA(At, 0, 0); PG8_STAGE(PG8_SA(1, 1), a1 + hstep, voffA);
            PG8_WAIT_L(8); PG8_BAR; PG8_WAIT_L(0); PG8_MMA(0, 0, At, B0); PG8_BAR; PG8_SCHED;
            PG8_LDB(B1, 0, 1); PG8_STAGE(PG8_SB(0, 0), b2, voffB);
            PG8_BAR; PG8_WAIT_L(0); PG8_MMA(0, 1, At, B1); PG8_BAR;
            PG8_LDA(At, 0, 1); PG8_STAGE(PG8_SA(0, 0), a2, voffA);
            PG8_BAR; PG8_WAIT_L(0); PG8_MMA(1, 0, At, B0); PG8_BAR; PG8_SCHED;
            PG8_STAGE(PG8_SB(0, 1), b2 + hstep, voffB);
            PG8_WAIT_V(6); PG8_BAR; PG8_MMA(1, 1, At, B1); PG8_BAR;
            PG8_LDB(B0, 1, 0); PG8_SCHED; PG8_LDA(At, 1, 0); PG8_STAGE(PG8_SA(0, 1), a2 + hstep, voffA);
            PG8_WAIT_L(8); PG8_BAR; PG8_WAIT_L(0); PG8_MMA(0, 0, At, B0); PG8_BAR; PG8_SCHED;
            PG8_LDB(B1, 1, 1); PG8_STAGE(PG8_SB(1, 0), b3, voffB);
            PG8_BAR; PG8_WAIT_L(0); PG8_MMA(0, 1, At, B1); PG8_BAR;
            PG8_LDA(At, 1, 1); PG8_STAGE(PG8_SA(1, 0), a3, voffA);
            PG8_BAR; PG8_WAIT_L(0); PG8_MMA(1, 0, At, B0); PG8_BAR; PG8_SCHED;
            PG8_STAGE(PG8_SB(1, 1), b3 + hstep, voffB);
            PG8_WAIT_V(6); PG8_BAR; PG8_MMA(1, 1, At, B1); PG8_BAR;
            }
        }
        if constexpr (ALIGN_EPI) { if (wr == 0) PG8_BAR; }
        if constexpr (!Epi::AFTER_DRAIN) { E(acc, cur, wr, wc, fr, fq); S.done(cur); }
        if (!has_next) break;
#pragma unroll
        for (int a = 0; a < 2; ++a)
#pragma unroll
            for (int b = 0; b < 2; ++b)
#pragma unroll
                for (int m = 0; m < 4; ++m)
#pragma unroll
                    for (int n = 0; n < 2; ++n) acc[a][b][m][n] = (f32x4){0.f, 0.f, 0.f, 0.f};
        cur = nxt; cA = nA; cB = nB; ++ui;
        if constexpr (ALIGN_EPI) { if (wr == 1) PG8_BAR; }
    }
    PG8_WAIT_V(0);
    if constexpr (!ALIGN_EPI) { if (wr == 0) PG8_BAR; }
    PG8_BAR;
    if constexpr (Epi::AFTER_DRAIN) { E.fused(acc, cur, wr, wc, fr, fq, lds, wid, lane); S.done(cur); }
#undef PG8_SA
#undef PG8_SB
#undef PG8_STAGE
#undef PG8_LDA
#undef PG8_LDB
#undef PG8_MMA
#undef PG8_WAIT_V
#undef PG8_WAIT_L
#undef PG8_BAR
#undef PG8_SCHED
}
}

typedef unsigned short bf16_t;
typedef short bf16x8 __attribute__((ext_vector_type(8)));
typedef short bf16x4 __attribute__((ext_vector_type(4)));
typedef float f32x4 __attribute__((ext_vector_type(4)));
typedef unsigned u32x4 __attribute__((ext_vector_type(4)));
typedef unsigned u32x2 __attribute__((ext_vector_type(2)));
#define LAS __attribute__((address_space(3)))

constexpr int DM = 2048, MP = 8192, MS = 512, MT = 8704, NP = 7168, FF = 8192;
constexpr int NH = 8, HD = 128, SEQ = 2048, DSEQ = 32, PAST = 2048, NB = 4, NDB = 16;
constexpr int NCH_P = 1024, NCH = 1152;
constexpr float ALPHA = 1.189207115002721f;
constexpr float QSCALE = 0.08838834764831845f;
constexpr float LN_EPS = 1e-5f, RMS_EPS = 1e-6f, L2_EPS = 1e-6f;
constexpr int NPHASE = 10;

constexpr size_t OUT_YP = 0, OUT_YS = OUT_YP + (size_t)MP * DM, OUT_CONVP = OUT_YS + (size_t)MS * DM, OUT_SP = OUT_CONVP + (size_t)NB * 3 * 3072,
    OUT_KP = OUT_SP + (size_t)NB * NH * HD * HD, OUT_VP = OUT_KP + (size_t)MP * 1024, OUT_CONVS = OUT_VP + (size_t)MP * 1024, OUT_SS = OUT_CONVS + (size_t)NDB * 3 * 3072,
    OUT_KS = OUT_SS + (size_t)NDB * NH * HD * HD, OUT_VS = OUT_KS + (size_t)MS * 1024, OUT_END = OUT_VS + (size_t)MS * 1024;

constexpr size_t MiB = 1u << 20;
constexpr size_t WS_CTL = 0, CTL_BYTES = 1 * MiB;
constexpr size_t WS_WIN = 1 * MiB, WS_WOUT = 29 * MiB, WS_WUP = 37 * MiB, WS_WDN = 69 * MiB, WS_XB = 101 * MiB, WS_BA = 135 * MiB;
constexpr size_t WS_PROJ = 136 * MiB, WS_VT = 255 * MiB, WS_H = 136 * MiB;
constexpr size_t WS_U = 272 * MiB, WS_NW = 308 * MiB, WS_QD = 326 * MiB, WS_KTT = 344 * MiB, WS_ATT = 362 * MiB, WS_GT = 371 * MiB;
constexpr size_t WS_OA = 372 * MiB, WS_MIX = 406 * MiB, WS_PO = 440 * MiB, WS_PR = 450 * MiB, WS_END = 451 * MiB;
constexpr size_t WS_Y1 = 272 * MiB, WS_X1 = 340 * MiB, WS_Y2 = 272 * MiB;
constexpr size_t WS_PART1 = 136 * MiB, WS_PART2 = 1 * MiB;
constexpr int NSPLIT1 = 8, NSPLIT2 = 16;
constexpr int LDS_BYTES = 147456;

__device__ __forceinline__ unsigned f2bf(float f) { unsigned u = __builtin_bit_cast(unsigned, f); return (u + 0x7fffu + ((u >> 16) & 1u)) >> 16; }
__device__ __forceinline__ unsigned pk2(float lo, float hi) { unsigned r; asm volatile("v_cvt_pk_bf16_f32 %0, %1, %2" : "=v"(r) : "v"(lo), "v"(hi)); return r; }
__device__ __forceinline__ float asf(unsigned u) { return __builtin_bit_cast(float, u); }
__device__ __forceinline__ float bflo(unsigned p) { return __builtin_bit_cast(float, p << 16); }
__device__ __forceinline__ float bfhi(unsigned p) { return __builtin_bit_cast(float, p & 0xffff0000u); }
__device__ __forceinline__ f32x4 mfma16(bf16x8 a, bf16x8 b, f32x4 c) { return __builtin_amdgcn_mfma_f32_16x16x32_bf16(a, b, c, 0, 0, 0); }
__device__ __forceinline__ float wave_sum(float v) {
#pragma unroll
    for (int o = 1; o < 64; o <<= 1) v += __shfl_xor(v, o);
    return v;
}
__device__ __forceinline__ float silu_f(float x) { return x / (1.f + __expf(-x)); }
#define LDS_FENCE() asm volatile("s_waitcnt lgkmcnt(0)" ::: "memory")

typedef __attribute__((address_space(4))) const unsigned char* kptr_t;
struct Ctx {
    kptr_t kp; unsigned char* lds;
    __device__ __forceinline__ int tid() const { return (int)threadIdx.x; }
    __device__ __forceinline__ int lane() const { return (int)threadIdx.x & 63; }
    __device__ __forceinline__ int wave() const { return __builtin_amdgcn_readfirstlane((int)threadIdx.x >> 6); }
    __device__ __forceinline__ int G_() const { return (int)gridDim.x; }
    __device__ __forceinline__ const float* in(int i) const { return *(const float* const __attribute__((address_space(4)))*)(kp + 8 * i); }
    __device__ __forceinline__ float* out_() const { return *(float* const __attribute__((address_space(4)))*)(kp + 144); }
    __device__ __forceinline__ unsigned char* ws_() const { return *(unsigned char* const __attribute__((address_space(4)))*)(kp + 152); }
    __device__ __forceinline__ const float* x_prompt() const { return in(0); }
    __device__ __forceinline__ const float* x_sample() const { return in(1); }
    __device__ __forceinline__ const float* st_conv() const { return in(2); }
    __device__ __forceinline__ const float* st_S() const { return in(3); }
    __device__ __forceinline__ const float* ck() const { return in(4); }
    __device__ __forceinline__ const float* cv() const { return in(5); }
    __device__ __forceinline__ const float* w_in() const { return in(6); }
    __device__ __forceinline__ const float* conv_w() const { return in(7); }
    __device__ __forceinline__ const float* a_log() const { return in(8); }
    __device__ __forceinline__ const float* dt_bias() const { return in(9); }
    __device__ __forceinline__ const float* gnorm_w() const { return in(10); }
    __device__ __forceinline__ const float* w_out() const { return in(11); }
    __device__ __forceinline__ const float* ln1_g() const { return in(12); }
    __device__ __forceinline__ const float* ln1_b() const { return in(13); }
    __device__ __forceinline__ const float* w_up() const { return in(14); }
    __device__ __forceinline__ const float* w_down() const { return in(15); }
    __device__ __forceinline__ const float* ln2_g() const { return in(16); }
    __device__ __forceinline__ const float* ln2_b() const { return in(17); }
    __device__ __forceinline__ bf16_t* WinT() const { return (bf16_t*)(ws_() + WS_WIN); }
    __device__ __forceinline__ bf16_t* WoutT() const { return (bf16_t*)(ws_() + WS_WOUT); }
    __device__ __forceinline__ bf16_t* WupT() const { return (bf16_t*)(ws_() + WS_WUP); }
    __device__ __forceinline__ bf16_t* WdnT() const { return (bf16_t*)(ws_() + WS_WDN); }
    __device__ __forceinline__ bf16_t* XB() const { return (bf16_t*)(ws_() + WS_XB); }
    __device__ __forceinline__ bf16_t* PROJ() const { return (bf16_t*)(ws_() + WS_PROJ); }
    __device__ __forceinline__ bf16_t* VT() const { return (bf16_t*)(ws_() + WS_VT); }
    __device__ __forceinline__ bf16_t* HB() const { return (bf16_t*)(ws_() + WS_H); }
    __device__ __forceinline__ bf16_t* NW() const { return (bf16_t*)(ws_() + WS_NW); }
    __device__ __forceinline__ bf16_t* QD() const { return (bf16_t*)(ws_() + WS_QD); }
    __device__ __forceinline__ bf16_t* KTT() const { return (bf16_t*)(ws_() + WS_KTT); }
    __device__ __forceinline__ bf16_t* ATT() const { return (bf16_t*)(ws_() + WS_ATT); }
    __device__ __forceinline__ bf16_t* MIX() const { return (bf16_t*)(ws_() + WS_MIX); }
    __device__ __forceinline__ float* BA() const { return (float*)(ws_() + WS_BA); }
    __device__ __forceinline__ float* U() const { return (float*)(ws_() + WS_U); }
    __device__ __forceinline__ float* GT() const { return (float*)(ws_() + WS_GT); }
    __device__ __forceinline__ float* OA() const { return (float*)(ws_() + WS_OA); }
    __device__ __forceinline__ float* PO() const { return (float*)(ws_() + WS_PO); }
    __device__ __forceinline__ float* PR() const { return (float*)(ws_() + WS_PR); }
    __device__ __forceinline__ float* Y1() const { return (float*)(ws_() + WS_Y1); }
    __device__ __forceinline__ float* X1() const { return (float*)(ws_() + WS_X1); }
    __device__ __forceinline__ float* Y2() const { return (float*)(ws_() + WS_Y2); }
    __device__ __forceinline__ float* PART1() const { return (float*)(ws_() + WS_PART1); }
    __device__ __forceinline__ float* PART2() const { return (float*)(ws_() + WS_PART2); }
    __device__ __forceinline__ float* out() const { return out_(); }
    __device__ __forceinline__ unsigned* ctl() const { return (unsigned*)(ws_() + WS_CTL); }
};

__device__ __forceinline__ void p0_transpose_item(const float* W, int ldw, int nblk, int K, bf16_t* WT, int row_off, float* scr, int item, int lane) {
    const int kb = item / nblk, nb = item % nblk, k0 = 64 * kb, n0 = 64 * nb;
    const int ks = lane >> 4, nq = lane & 15;
    f32x4 v[16];
#pragma unroll
    for (int i = 0; i < 16; ++i) v[i] = *(const f32x4*)(W + (size_t)(k0 + 4 * i + ks) * ldw + n0 + 4 * nq);
#pragma unroll
    for (int i = 0; i < 16; ++i) { float* d = scr + (4 * i + ks) * 65 + 4 * nq; d[0] = v[i][0]; d[1] = v[i][1]; d[2] = v[i][2]; d[3] = v[i][3]; }
    LDS_FENCE();
    const int c = lane & 7;
#pragma unroll
    for (int j = 0; j < 8; ++j) { const int n = (lane >> 3) + 8 * j; const float* s = scr + (8 * c) * 65 + n;
        u32x4 o; o.x = pk2(s[0 * 65], s[1 * 65]); o.y = pk2(s[2 * 65], s[3 * 65]); o.z = pk2(s[4 * 65], s[5 * 65]); o.w = pk2(s[6 * 65], s[7 * 65]);
        *(u32x4*)(WT + (size_t)(row_off + n0 + n) * K + k0 + 8 * c) = o; }
    LDS_FENCE();
}
__device__ __forceinline__ void p0_load_x(f32x4 (&v)[8], Ctx& F, int m, int lane) {
    const float* xr = (m < MP) ? F.x_prompt() + (size_t)m * DM : F.x_sample() + (size_t)(m - MP) * DM;
#pragma unroll
    for (int j = 0; j < 8; ++j) v[j] = ((const f32x4*)xr)[64 * j + lane];
}
constexpr int I_IN1 = 32 * 64, I_IN2 = 32 * 48, I_OUT = 32 * 32, I_UP = 32 * 128, I_DN = 128 * 32;
constexpr int NT_EARLY = I_IN1 + I_IN2, NT_LATE = I_OUT + I_UP + I_DN;
__device__ __forceinline__ void p0_transpose_any(Ctx& F, int it, float* scr) {
    int r = it; const float* W; int ldw, nblk, K, roff; bf16_t* WT;
    if (r < I_IN1) { W = F.w_in(); ldw = 7184; nblk = 64; K = DM; WT = F.WinT(); roff = 0; }
    else if ((r -= I_IN1) < I_IN2) { W = F.w_in() + 4112; ldw = 7184; nblk = 48; K = DM; WT = F.WinT(); roff = 4096; }
    else if ((r -= I_IN2) < I_OUT) { W = F.w_out(); ldw = DM; nblk = 32; K = DM; WT = F.WoutT(); roff = 0; }
    else if ((r -= I_OUT) < I_UP) { W = F.w_up(); ldw = FF; nblk = 128; K = DM; WT = F.WupT(); roff = 0; }
    else { r -= I_UP; W = F.w_down(); ldw = DM; nblk = 32; K = FF; WT = F.WdnT(); roff = 0; }
    p0_transpose_item(W, ldw, nblk, K, WT, roff, scr, r, F.lane());
}
__device__ __forceinline__ void p0_prologue(Ctx& F) {
    float* scr = (float*)(F.lds + F.wave() * 16640);
    const int gw = blockIdx.x * 8 + F.wave(), NGW = F.G_() * 8;
    for (int it = gw; it < NT_EARLY; it += NGW) p0_transpose_any(F, it, scr);
    __syncthreads();
    float* wT = (float*)F.lds;
    for (int k = F.tid(); k < DM; k += 512) {
        const float* src = F.w_in() + (size_t)k * 7184 + 4096;
#pragma unroll
        for (int q = 0; q < 4; ++q) { const f32x4 v = *(const f32x4*)(src + 4 * q); wT[(4 * q + 0) * DM + k] = v[0]; wT[(4 * q + 1) * DM + k] = v[1]; wT[(4 * q + 2) * DM + k] = v[2]; wT[(4 * q + 3) * DM + k] = v[3]; }
    }
    __syncthreads();
    f32x4 nv[8];
    if (gw < MT) p0_load_x(nv, F, gw, F.lane());
    for (int m = gw; m < MT; m += NGW) {
        f32x4 v[8];
#pragma unroll
        for (int j = 0; j < 8; ++j) v[j] = nv[j];
        if (m + NGW < MT) p0_load_x(nv, F, m + NGW, F.lane());
        bf16_t* xb = F.XB() + (size_t)m * DM;
#pragma unroll
        for (int j = 0; j < 8; ++j) { u32x2 o; o.x = pk2(v[j][0], v[j][1]); o.y = pk2(v[j][2], v[j][3]); *(u32x2*)(xb + 256 * j + 4 * F.lane()) = o; }
        float mine = 0.f;
#pragma unroll
        for (int c = 0; c < 16; ++c) {
            float s = 0.f;
#pragma unroll
            for (int j = 0; j < 8; ++j) { const f32x4 w = *(const f32x4*)(wT + c * DM + 256 * j + 4 * F.lane()); s += v[j][0] * w[0] + v[j][1] * w[1] + v[j][2] * w[2] + v[j][3] * w[3]; }
            s = wave_sum(s);
            if (F.lane() == c) mine = s;
        }
        if (F.lane() < 16) F.BA()[(size_t)m * 16 + F.lane()] = mine;
    }
}

constexpr int PL_KN = 0, PL_QN = 17408, PL_VBT = 34816, PL_KBGT = 53248, PL_KTT = 71680, PL_MM = 90112, PL_TB = 107520, PL_SM = 116736;
template <int C> __device__ __forceinline__ void gdn_prep(Ctx& F, bool sample, int b, int h, int n, int chunk) {
    bf16_t* KN = (bf16_t*)(F.lds + PL_KN); bf16_t* QN = (bf16_t*)(F.lds + PL_QN); bf16_t* VBt = (bf16_t*)(F.lds + PL_VBT); bf16_t* KBGt = (bf16_t*)(F.lds + PL_KBGT);
    bf16_t* KTt = (bf16_t*)(F.lds + PL_KTT); float* MM = (float*)(F.lds + PL_MM); bf16_t* Tb = (bf16_t*)(F.lds + PL_TB);
    float* s_beta = (float*)(F.lds + PL_SM); float* s_gc = s_beta + 64; float* s_egc = s_beta + 128;
    const int lane = F.lane(), wave = F.wave(), tid = F.tid(), fr = lane & 15, g = lane >> 4;
    const int seqrow = sample ? MP + b * DSEQ : b * SEQ;
    const int tpos0 = n * C;
    const int m0 = seqrow + tpos0;
    if (wave == 0) {
        float beta = 0.f, gg = 0.f;
        if (lane < C) {
            const float bl = F.BA()[(size_t)(m0 + lane) * 16 + h], al = F.BA()[(size_t)(m0 + lane) * 16 + 8 + h];
            beta = 1.f / (1.f + expf(-bl));
            const float xx = al + F.dt_bias()[h];
            const float sp = xx > 20.f ? xx : log1pf(expf(xx));
            gg = -expf(F.a_log()[h]) * sp;
        }
        float gc = gg;
#pragma unroll
        for (int o = 1; o < 64; o <<= 1) { const float t = __shfl_up(gc, o); if (lane >= o) gc += t; }
        if (lane < C) { s_beta[lane] = beta; s_gc[lane] = gc; s_egc[lane] = expf(gc); }
    }
    __syncthreads();
    const float gcl = s_gc[C - 1];
    {
        constexpr int TPW = C / 8, NRW = TPW + 3;
        float u0[3][NRW], u1[3][NRW];
#pragma unroll
        for (int which = 0; which < 3; ++which) {
            const int col = which * 1024 + h * 128 + 2 * lane;
#pragma unroll
            for (int r = 0; r < NRW; ++r) {
                const int pos = tpos0 + TPW * wave - 3 + r;
                if (pos >= 0) { const unsigned pk = *(const unsigned*)(F.PROJ() + (size_t)(seqrow + pos) * NP + col); u0[which][r] = bflo(pk); u1[which][r] = bfhi(pk); }
                else if (sample) { const float* s = F.st_conv() + (size_t)(b * 3 + pos + 3) * 3072 + col; u0[which][r] = s[0]; u1[which][r] = s[1]; }
                else { u0[which][r] = 0.f; u1[which][r] = 0.f; }
            }
        }
#pragma unroll
        for (int which = 0; which < 3; ++which) {
            const int col = which * 1024 + h * 128 + 2 * lane;
            float cw0[4], cw1[4];
#pragma unroll
            for (int i = 0; i < 4; ++i) { cw0[i] = F.conv_w()[i * 3072 + col]; cw1[i] = F.conv_w()[i * 3072 + col + 1]; }
#pragma unroll
            for (int tt = 0; tt < TPW; ++tt) {
                const int t = TPW * wave + tt;
                float x0 = 0.f, x1 = 0.f;
#pragma unroll
                for (int i = 0; i < 4; ++i) { x0 += cw0[i] * u0[which][tt + i]; x1 += cw1[i] * u1[which][tt + i]; }
                x0 = silu_f(x0); x1 = silu_f(x1);
                const float bt = s_beta[t], egc = s_egc[t];
                if (which == 0) {
                    const float rs = rsqrtf(wave_sum(x0 * x0 + x1 * x1) + L2_EPS);
                    x0 *= rs; x1 *= rs;
                    *(unsigned*)(QN + t * 136 + 2 * lane) = pk2(x0, x1);
                    const float f = QSCALE * egc;
                    *(unsigned*)(F.QD() + (size_t)chunk * 8192 + t * 128 + 2 * lane) = pk2(x0 * f, x1 * f);
                } else if (which == 1) {
                    const float rs = rsqrtf(wave_sum(x0 * x0 + x1 * x1) + L2_EPS);
                    x0 *= rs; x1 *= rs;
                    *(unsigned*)(KN + t * 136 + 2 * lane) = pk2(x0, x1);
                    const float f = bt * egc, f2 = expf(gcl - s_gc[t]);
                    KBGt[(2 * lane) * 72 + t] = (bf16_t)f2bf(x0 * f); KBGt[(2 * lane + 1) * 72 + t] = (bf16_t)f2bf(x1 * f);
                    KTt[(2 * lane) * 72 + t] = (bf16_t)f2bf(x0 * f2); KTt[(2 * lane + 1) * 72 + t] = (bf16_t)f2bf(x1 * f2);
                } else {
                    VBt[(2 * lane) * 72 + t] = (bf16_t)f2bf(x0 * bt); VBt[(2 * lane + 1) * 72 + t] = (bf16_t)f2bf(x1 * bt);
                }
            }
        }
    }
    __syncthreads();
    constexpr int NT = C / 16;
    for (int tile = wave; tile < NT * NT; tile += 8) {
        const int it = tile / NT, jt = tile % NT;
        f32x4 akk = {0.f, 0.f, 0.f, 0.f}, aqk = {0.f, 0.f, 0.f, 0.f};
#pragma unroll
        for (int ks = 0; ks < 4; ++ks) {
            const bf16x8 ki = *(const bf16x8*)(KN + (16 * it + fr) * 136 + 32 * ks + 8 * g);
            const bf16x8 kj = *(const bf16x8*)(KN + (16 * jt + fr) * 136 + 32 * ks + 8 * g);
            const bf16x8 qi = *(const bf16x8*)(QN + (16 * it + fr) * 136 + 32 * ks + 8 * g);
            akk = mfma16(ki, kj, akk);
            aqk = mfma16(kj, qi, aqk);
        }
        {   const int j = 16 * jt + fr; const float gj = s_gc[j];
#pragma unroll
            for (int jj = 0; jj < 4; ++jj) { const int i = 16 * it + 4 * g + jj; MM[i * 68 + j] = (i > j) ? s_beta[i] * akk[jj] * __expf(s_gc[i] - gj) : 0.f; } }
        {   const int i = 16 * it + fr; const float gi = s_gc[i]; float v[4];
#pragma unroll
            for (int jj = 0; jj < 4; ++jj) { const int j = 16 * jt + 4 * g + jj; v[jj] = (i >= j) ? aqk[jj] * QSCALE * __expf(gi - s_gc[j]) : 0.f; }
            u32x2 o; o.x = pk2(v[0], v[1]); o.y = pk2(v[2], v[3]);
            *(u32x2*)(F.ATT() + (size_t)chunk * 4096 + i * C + 16 * jt + 4 * g) = o; }
    }
    __syncthreads();
    if (wave == 0) {
        float tc[C];
        const float* MMv = MM; asm volatile("" : "+v"(MMv));
#pragma unroll
        for (int i = 0; i < C; ++i) {
            float a0 = (i == lane) ? 1.f : 0.f, a1 = 0.f, a2 = 0.f, a3 = 0.f;
#pragma unroll
            for (int j4 = 0; j4 < i; j4 += 4) {
                const f32x4 mv = *(const f32x4*)(MMv + i * 68 + j4);
                a0 -= mv[0] * tc[j4];
                if (j4 + 1 < i) a1 -= mv[1] * tc[j4 + 1];
                if (j4 + 2 < i) a2 -= mv[2] * tc[j4 + 2];
                if (j4 + 3 < i) a3 -= mv[3] * tc[j4 + 3];
            }
            tc[i] = (a0 + a1) + (a2 + a3);
        }
        if (lane < C) {
#pragma unroll
            for (int i = 0; i < C; ++i) Tb[i * 72 + lane] = (bf16_t)f2bf(tc[i]);
        }
    }
    __syncthreads();
    for (int job = wave; job < 2 * 8 * NT; job += 8) {
        const int mat = job / (8 * NT), dt = (job / NT) % 8, it = job % NT;
        const bf16_t* X = mat ? KBGt : VBt;
        f32x4 acc = {0.f, 0.f, 0.f, 0.f};
#pragma unroll
        for (int ks = 0; ks < C / 32; ++ks) {
            const bf16x8 a = *(const bf16x8*)(X + (16 * dt + fr) * 72 + 32 * ks + 8 * g);
            const bf16x8 bb = *(const bf16x8*)(Tb + (16 * it + fr) * 72 + 32 * ks + 8 * g);
            acc = mfma16(a, bb, acc);
        }
        const int i = 16 * it + fr, d0 = 16 * dt + 4 * g;
        if (mat == 0) *(f32x4*)(F.U() + (size_t)chunk * 8192 + i * 128 + d0) = acc;
        else { u32x2 o; o.x = pk2(-acc[0], -acc[1]); o.y = pk2(-acc[2], -acc[3]); *(u32x2*)(F.NW() + (size_t)chunk * 8192 + i * 128 + d0) = o; }
    }
    for (int idx = tid; idx < 128 * (C / 8); idx += 512) {
        const int d = idx / (C / 8), c8 = idx % (C / 8);
        *(u32x4*)(F.KTT() + (size_t)chunk * 8192 + d * C + c8 * 8) = *(const u32x4*)(KTt + d * 72 + c8 * 8);
    }
    if (tid == 0) F.GT()[chunk * 32] = expf(gcl);
    __syncthreads();
}
__device__ __forceinline__ void vt_item(Ctx& F, int wi) {
    bf16_t* tile = (bf16_t*)(F.lds + F.wave() * 8448);
    const int m0 = 64 * (wi >> 4), f0 = 64 * (wi & 15), lane = F.lane();
#pragma unroll 8
    for (int r = 0; r < 64; ++r) tile[r * 66 + lane] = F.PROJ()[(size_t)(m0 + r) * NP + 6144 + f0 + lane];
    LDS_FENCE();
#pragma unroll 8
    for (int f = 0; f < 64; ++f) F.VT()[(size_t)(f0 + f) * MT + m0 + lane] = tile[lane * 66 + f];
    LDS_FENCE();
}
__device__ __forceinline__ void p2_prep(Ctx& F) {
    constexpr int N_VT = (MT / 64) * 16 / 8;
    for (int it = blockIdx.x; it < NCH + N_VT; it += F.G_()) {
        if (it < NCH_P) { const int b = it >> 8, h = (it >> 5) & 7, n = it & 31; gdn_prep<64>(F, false, b, h, n, it); }
        else if (it < NCH) { const int bh = it - NCH_P; gdn_prep<32>(F, true, bh >> 3, bh & 7, 0, it); }
        else { vt_item(F, (it - NCH) * 8 + F.wave()); __syncthreads(); }
    }
}

constexpr int SL_ST = 0, SL_VN = 8704;
template <int C> struct ScanOps { bf16x8 bw[4], bq[4], ba[C / 32], bk[2][C / 32]; f32x4 u; float gt; };
template <int C> __device__ __forceinline__ void scan_load(Ctx& F, ScanOps<C>& o, int chunk, bool act, int c, int sl, int mt, int nt0, int fr, int g) {
    const bf16_t* NWc = F.NW() + (size_t)chunk * 8192; const bf16_t* QDc = F.QD() + (size_t)chunk * 8192;
    const bf16_t* ATc = F.ATT() + (size_t)chunk * 4096; const bf16_t* KTc = F.KTT() + (size_t)chunk * 8192; const float* Uc = F.U() + (size_t)chunk * 8192;
    o.gt = F.GT()[chunk * 32];
    if (act) {
        o.u = *(const f32x4*)(Uc + c * 128 + 32 * sl + 16 * mt + 4 * g);
#pragma unroll
        for (int ks = 0; ks < 4; ++ks) { o.bw[ks] = *(const bf16x8*)(NWc + c * 128 + 32 * ks + 8 * g); o.bq[ks] = *(const bf16x8*)(QDc + c * 128 + 32 * ks + 8 * g); }
#pragma unroll
        for (int ks = 0; ks < C / 32; ++ks) o.ba[ks] = *(const bf16x8*)(ATc + c * C + 32 * ks + 8 * g);
    }
#pragma unroll
    for (int i = 0; i < 2; ++i)
#pragma unroll
        for (int ks = 0; ks < C / 32; ++ks) o.bk[i][ks] = *(const bf16x8*)(KTc + (16 * (nt0 + i) + fr) * C + 32 * ks + 8 * g);
}
template <int C> __device__ __forceinline__ void scan_step(Ctx& F, ScanOps<C>& o, bool reload, int cnext, f32x4 (&accS)[2], bf16_t* St, bf16_t* VNt, bool act, int c, int row, int h, int sl, int mt, int nt0, int fr, int g) {
    f32x4 accV = {0.f, 0.f, 0.f, 0.f}, accO = {0.f, 0.f, 0.f, 0.f};
    const float gt = o.gt;
    if (act) {
        accV = o.u;
#pragma unroll
        for (int ks = 0; ks < 4; ++ks) {
            const bf16x8 a = *(const bf16x8*)(St + (16 * mt + fr) * 136 + 32 * ks + 8 * g);
            accV = mfma16(a, o.bw[ks], accV);
            accO = mfma16(a, o.bq[ks], accO);
        }
        if (reload) {
            const bf16_t* NWc = F.NW() + (size_t)cnext * 8192; const bf16_t* QDc = F.QD() + (size_t)cnext * 8192;
            o.u = *(const f32x4*)(F.U() + (size_t)cnext * 8192 + c * 128 + 32 * sl + 16 * mt + 4 * g);
#pragma unroll
            for (int ks = 0; ks < 4; ++ks) { o.bw[ks] = *(const bf16x8*)(NWc + c * 128 + 32 * ks + 8 * g); o.bq[ks] = *(const bf16x8*)(QDc + c * 128 + 32 * ks + 8 * g); }
        }
#pragma unroll
        for (int jj = 0; jj < 4; ++jj) VNt[(16 * mt + 4 * g + jj) * 72 + c] = (bf16_t)f2bf(accV[jj]);
    }
    __syncthreads();
    if (act) {
#pragma unroll
        for (int ks = 0; ks < C / 32; ++ks) {
            const bf16x8 a = *(const bf16x8*)(VNt + (16 * mt + fr) * 72 + 32 * ks + 8 * g);
            accO = mfma16(a, o.ba[ks], accO);
        }
        if (reload) {
#pragma unroll
            for (int ks = 0; ks < C / 32; ++ks) o.ba[ks] = *(const bf16x8*)(F.ATT() + (size_t)cnext * 4096 + c * C + 32 * ks + 8 * g);
        }
        *(f32x4*)(F.OA() + (size_t)row * 1024 + h * 128 + 32 * sl + 16 * mt + 4 * g) = accO;
    }
#pragma unroll
    for (int i = 0; i < 2; ++i) {
        accS[i] = accS[i] * gt;
        const int d = 16 * (nt0 + i) + fr;
#pragma unroll
        for (int ks = 0; ks < C / 32; ++ks) {
            const bf16x8 a = *(const bf16x8*)(VNt + (16 * mt + fr) * 72 + 32 * ks + 8 * g);
            accS[i] = mfma16(a, o.bk[i][ks], accS[i]);
        }
        if (reload) {
#pragma unroll
            for (int ks = 0; ks < C / 32; ++ks) o.bk[i][ks] = *(const bf16x8*)(F.KTT() + (size_t)cnext * 8192 + d * C + 32 * ks + 8 * g);
        }
#pragma unroll
        for (int jj = 0; jj < 4; ++jj) St[(16 * mt + 4 * g + jj) * 136 + d] = (bf16_t)f2bf(accS[i][jj]);
    }
    if (reload) o.gt = F.GT()[cnext * 32];
    __syncthreads();
}
template <int C> __device__ __forceinline__ void gdn_scan(Ctx& F, int chunk0, int nsteps, int m0, int h, int sl, const float* S0, float* Sout) {
    bf16_t* St = (bf16_t*)(F.lds + SL_ST); bf16_t* VNt = (bf16_t*)(F.lds + SL_VN);
    const int lane = F.lane(), wave = F.wave(), fr = lane & 15, g = lane >> 4;
    const int mt = wave & 1, ct = wave >> 1, nt0 = (wave >> 1) * 2;
    const bool act = ct < C / 16;
    const int c = 16 * ct + fr;
    ScanOps<C> A, B;
    scan_load<C>(F, A, chunk0, act, c, sl, mt, nt0, fr, g);
    if (nsteps > 1) scan_load<C>(F, B, chunk0 + 1, act, c, sl, mt, nt0, fr, g);
    f32x4 accS[2];
#pragma unroll
    for (int i = 0; i < 2; ++i) {
        const int d = 16 * (nt0 + i) + fr;
        accS[i] = S0 ? *(const f32x4*)(S0 + (size_t)d * 128 + 32 * sl + 16 * mt + 4 * g) : (f32x4){0.f, 0.f, 0.f, 0.f};
    }
    __syncthreads();
#pragma unroll
    for (int i = 0; i < 2; ++i)
#pragma unroll
        for (int jj = 0; jj < 4; ++jj) St[(16 * mt + 4 * g + jj) * 136 + 16 * (nt0 + i) + fr] = (bf16_t)f2bf(accS[i][jj]);
    __syncthreads();
    for (int s = 0; s < nsteps; s += 2) {
        scan_step<C>(F, A, s + 2 < nsteps, chunk0 + s + 2, accS, St, VNt, act, c, m0 + s * C + c, h, sl, mt, nt0, fr, g);
        if (s + 1 >= nsteps) break;
        scan_step<C>(F, B, s + 3 < nsteps, chunk0 + s + 3, accS, St, VNt, act, c, m0 + (s + 1) * C + c, h, sl, mt, nt0, fr, g);
    }
#pragma unroll
    for (int i = 0; i < 2; ++i) { const int d = 16 * (nt0 + i) + fr; *(f32x4*)(Sout + (size_t)d * 128 + 32 * sl + 16 * mt + 4 * g) = accS[i]; }
}

struct SbState { bf16x8 qf[4]; f32x4 oacc[8]; float R; };
constexpr int AL_K = 0, AL_V = 17408;
template <bool F32SRC> __device__ __forceinline__ void sb_tiles(Ctx& F, SbState& st, bool act, int qpos, int mask_from, int t_lo, int t_hi, int seq_len,
                                                               const bf16_t* kb, const bf16_t* vt, const float* kf, const float* vf) {
    bf16_t* Ks = (bf16_t*)(F.lds + AL_K); bf16_t* Vts = (bf16_t*)(F.lds + AL_V);
    const int lane = F.lane(), tid = F.tid(), fr = lane & 15, g = lane >> 4;
    constexpr int NR = F32SRC ? 4 : 2;
    u32x4 kreg[NR], vreg[NR];
#define SB_LOAD(t) do { _Pragma("unroll") for (int it_ = 0; it_ < 2; ++it_) { const int idx_ = tid + 512 * it_; \
        if (F32SRC) { const int row_ = idx_ >> 4, cc_ = idx_ & 15; const float* s_ = kf + (size_t)((t) * 64 + row_) * 1024 + cc_ * 8; \
            kreg[2 * it_] = *(const u32x4*)s_; kreg[2 * it_ + 1] = *(const u32x4*)(s_ + 4); \
            const int key_ = idx_ & 63, c2_ = idx_ >> 6; const float* v_ = vf + (size_t)((t) * 64 + key_) * 1024 + c2_ * 8; \
            vreg[2 * it_] = *(const u32x4*)v_; vreg[2 * it_ + 1] = *(const u32x4*)(v_ + 4); } \
        else { const int row_ = idx_ >> 4, cc_ = idx_ & 15; const int key_ = (t) * 64 + row_; \
            kreg[it_] = (key_ < seq_len) ? *(const u32x4*)(kb + (size_t)key_ * NP + cc_ * 8) : (u32x4){0u, 0u, 0u, 0u}; \
            const int d_ = idx_ >> 3, c8_ = idx_ & 7; const int tok_ = (t) * 64 + c8_ * 8; \
            vreg[it_] = (tok_ < seq_len) ? *(const u32x4*)(vt + (size_t)d_ * MT + tok_) : (u32x4){0u, 0u, 0u, 0u}; } } } while (0)
#define SB_STORE() do { _Pragma("unroll") for (int it_ = 0; it_ < 2; ++it_) { const int idx_ = tid + 512 * it_; \
        if (F32SRC) { const int row_ = idx_ >> 4, cc_ = idx_ & 15; const u32x4 a_ = kreg[2 * it_], b_ = kreg[2 * it_ + 1]; u32x4 o_; \
            o_.x = pk2(asf(a_.x), asf(a_.y)); o_.y = pk2(asf(a_.z), asf(a_.w)); \
            o_.z = pk2(asf(b_.x), asf(b_.y)); o_.w = pk2(asf(b_.z), asf(b_.w)); \
            *(u32x4*)(Ks + row_ * 136 + cc_ * 8) = o_; \
            const int key_ = idx_ & 63, c2_ = idx_ >> 6; const u32x4 c_ = vreg[2 * it_], d2_ = vreg[2 * it_ + 1]; \
            Vts[(c2_ * 8 + 0) * 72 + key_] = (bf16_t)f2bf(asf(c_.x)); Vts[(c2_ * 8 + 1) * 72 + key_] = (bf16_t)f2bf(asf(c_.y)); \
            Vts[(c2_ * 8 + 2) * 72 + key_] = (bf16_t)f2bf(asf(c_.z)); Vts[(c2_ * 8 + 3) * 72 + key_] = (bf16_t)f2bf(asf(c_.w)); \
            Vts[(c2_ * 8 + 4) * 72 + key_] = (bf16_t)f2bf(asf(d2_.x)); Vts[(c2_ * 8 + 5) * 72 + key_] = (bf16_t)f2bf(asf(d2_.y)); \
            Vts[(c2_ * 8 + 6) * 72 + key_] = (bf16_t)f2bf(asf(d2_.z)); Vts[(c2_ * 8 + 7) * 72 + key_] = (bf16_t)f2bf(asf(d2_.w)); } \
        else { const int row_ = idx_ >> 4, cc_ = idx_ & 15; *(u32x4*)(Ks + row_ * 136 + cc_ * 8) = kreg[it_]; \
            const int d_ = idx_ >> 3, c8_ = idx_ & 7; *(u32x4*)(Vts + d_ * 72 + c8_ * 8) = vreg[it_]; } } } while (0)
    if (!__syncthreads_or(act && st.R != 0.f)) return;
    SB_LOAD(t_hi - 1);
    for (int t = t_hi - 1; t >= t_lo; --t) {
        if (t != t_hi - 1 && !__syncthreads_or(act && st.R != 0.f)) break;
        SB_STORE();
        __syncthreads();
        if (t > t_lo) SB_LOAD(t - 1);
        if (act) {
            f32x4 sc[4];
#pragma unroll
            for (int mt = 0; mt < 4; ++mt) {
                sc[mt] = (f32x4){0.f, 0.f, 0.f, 0.f};
#pragma unroll
                for (int ks = 0; ks < 4; ++ks) sc[mt] = mfma16(*(const bf16x8*)(Ks + (16 * mt + fr) * 136 + 32 * ks + 8 * g), st.qf[ks], sc[mt]);
            }
            const bool masked = t >= mask_from;
            float wt[4][4], T[4], PH[4];
            const float cexp = QSCALE * 1.4426950408889634f;
#pragma unroll
            for (int mt = 0; mt < 4; ++mt) {
                float om[4];
#pragma unroll
                for (int jj = 0; jj < 4; ++jj) {
                    const float x = fminf(sc[mt][jj] * cexp, 100.f);
                    const float e = __builtin_amdgcn_exp2f(x);
                    const float r = __builtin_amdgcn_rcpf(1.f + e);
                    float bt = e * r, o1 = r;
                    if (masked) { const bool valid = (t * 64 + 16 * mt + 4 * g + jj) < qpos; bt = valid ? bt : 0.f; o1 = valid ? o1 : 1.f; }
                    wt[mt][jj] = bt; om[jj] = o1;
                }
                const float e2 = om[3], e1 = om[3] * om[2], e0 = e1 * om[1], G = e0 * om[0];
                wt[mt][3] *= 1.f; wt[mt][2] *= e2; wt[mt][1] *= e1; wt[mt][0] *= e0;
                const float y1 = __shfl_xor(G, 16), y2 = __shfl_xor(G, 32), y3 = __shfl_xor(G, 48);
                T[mt] = G * y1 * y2 * y3;
                PH[mt] = (((g ^ 1) > g) ? y1 : 1.f) * (((g ^ 2) > g) ? y2 : 1.f) * (((g ^ 3) > g) ? y3 : 1.f);
            }
            float suf = st.R;
#pragma unroll
            for (int mt = 3; mt >= 0; --mt) {
                const float f = suf * PH[mt];
#pragma unroll
                for (int jj = 0; jj < 4; ++jj) wt[mt][jj] *= f;
                suf *= T[mt];
            }
            st.R = suf;
            bf16x8 pf[2];
#pragma unroll
            for (int s = 0; s < 2; ++s) {
                u32x4 p; p.x = pk2(wt[2 * s][0], wt[2 * s][1]); p.y = pk2(wt[2 * s][2], wt[2 * s][3]); p.z = pk2(wt[2 * s + 1][0], wt[2 * s + 1][1]); p.w = pk2(wt[2 * s + 1][2], wt[2 * s + 1][3]);
                pf[s] = __builtin_bit_cast(bf16x8, p);
            }
#pragma unroll
            for (int dt = 0; dt < 8; ++dt)
#pragma unroll
                for (int s = 0; s < 2; ++s) {
                    const bf16_t* vp = Vts + (16 * dt + fr) * 72 + 32 * s + 4 * g;
                    const u32x2 lo = *(const u32x2*)vp, hi = *(const u32x2*)(vp + 16);
                    const u32x4 a = {lo.x, lo.y, hi.x, hi.y};
                    st.oacc[dt] = mfma16(__builtin_bit_cast(bf16x8, a), pf[s], st.oacc[dt]);
                }
        }
    }
#undef SB_LOAD
#undef SB_STORE
}
__device__ __forceinline__ void sb_init(Ctx& F, SbState& st, bool act, const bf16_t* q) {
    const int lane = F.lane(), wave = F.wave(), fr = lane & 15, g = lane >> 4;
#pragma unroll
    for (int ks = 0; ks < 4; ++ks) st.qf[ks] = act ? *(const bf16x8*)(q + (size_t)(16 * wave + fr) * NP + 32 * ks + 8 * g) : (bf16x8){0, 0, 0, 0, 0, 0, 0, 0};
#pragma unroll
    for (int dt = 0; dt < 8; ++dt) st.oacc[dt] = (f32x4){0.f, 0.f, 0.f, 0.f};
    st.R = 1.f;
}
__device__ __forceinline__ void sb_store(Ctx& F, const SbState& st, bool act, bf16_t* o_bf) {
    const int lane = F.lane(), wave = F.wave(), fr = lane & 15, g = lane >> 4;
    if (act) {
        const int qi = 16 * wave + fr;
#pragma unroll
        for (int dt = 0; dt < 8; ++dt) { u32x2 o; o.x = pk2(st.oacc[dt][0], st.oacc[dt][1]); o.y = pk2(st.oacc[dt][2], st.oacc[dt][3]); *(u32x2*)(o_bf + (size_t)qi * DM + 16 * dt + 4 * g) = o; }
    }
}

constexpr int Q3_SCANP = 128, Q3_SBP = Q3_SCANP + 512, Q3_SBS = Q3_SBP + 128, Q3_SCANS = Q3_SBS + 512;
constexpr int LT_P1 = 72 * 8 * 6;
__device__ __forceinline__ void p3_mix(Ctx& F) {
    volatile int* slot = (volatile int*)(F.lds + LDS_BYTES - 64);
    unsigned* ctr = F.ctl() + 64;
    const bool shared = (F.G_() == 256);
    const int lt0 = shared ? LT_P1 : 0, lt1 = shared ? I_OUT + I_UP : NT_LATE, q3_end = Q3_SCANS + (lt1 - lt0) / 8;
    for (;;) {
        __syncthreads();
        if (F.tid() == 0) *slot = (int)atomicAdd(ctr, 1u);
        __syncthreads();
        const int it = *slot;
        if (it >= q3_end) break;
        if (it < Q3_SCANP) {
            const int b = it >> 5, h = (it >> 2) & 7, sl = it & 3;
            gdn_scan<64>(F, (b * 8 + h) * 32, 32, b * SEQ, h, sl, nullptr, F.out() + OUT_SP + (size_t)(b * 8 + h) * 16384);
        } else if (it < Q3_SBP) {
            const int idx = it - Q3_SCANP, qb = 15 - (idx >> 5), bh = idx & 31, b = bh >> 3, h = bh & 7;
            const int qrow = b * SEQ + 128 * qb; const int wave = F.wave(), fr = F.lane() & 15;
            SbState st; sb_init(F, st, true, F.PROJ() + (size_t)qrow * NP + 4096 + h * 128);
            sb_tiles<false>(F, st, true, 128 * qb + 16 * wave + fr, 2 * qb, 0, 2 * qb + 2, SEQ,
                            F.PROJ() + (size_t)(b * SEQ) * NP + 5120 + h * 128, F.VT() + (size_t)(h * 128) * MT + b * SEQ, nullptr, nullptr);
            sb_store(F, st, true, F.MIX() + (size_t)qrow * DM + 1024 + h * 128);
        } else if (it < Q3_SBS) {
            const int bh = it - Q3_SBP, b = bh >> 3, h = bh & 7;
            const int qrow = MP + b * DSEQ; const int wave = F.wave(), fr = F.lane() & 15; const bool act = wave < 2;
            SbState st; sb_init(F, st, act, F.PROJ() + (size_t)qrow * NP + 4096 + h * 128);
            sb_tiles<false>(F, st, act, 16 * wave + fr, 0, 0, 1, DSEQ,
                            F.PROJ() + (size_t)qrow * NP + 5120 + h * 128, F.VT() + (size_t)(h * 128) * MT + qrow, nullptr, nullptr);
            sb_tiles<true>(F, st, act, 0, 1 << 30, 0, PAST / 64, PAST, nullptr, nullptr,
                           F.ck() + ((size_t)b * PAST * NH + h) * HD, F.cv() + ((size_t)b * PAST * NH + h) * HD);
            sb_store(F, st, act, F.MIX() + (size_t)qrow * DM + 1024 + h * 128);
        } else if (it < Q3_SCANS) {
            const int idx = it - Q3_SBS, bh = idx >> 2, sl = idx & 3, b = bh >> 3, h = bh & 7;
            gdn_scan<32>(F, NCH_P + bh, 1, MP + b * DSEQ, h, sl, F.st_S() + (size_t)bh * 16384, F.out() + OUT_SS + (size_t)bh * 16384);
        } else {
            p0_transpose_any(F, NT_EARLY + lt0 + (it - Q3_SCANS) * 8 + F.wave(), (float*)(F.lds + F.wave() * 16640));
        }
    }
}

__device__ __forceinline__ void p4_finalize(Ctx& F) {
    const int gw = blockIdx.x * 8 + F.wave(), NGW = F.G_() * 8, lane = F.lane();
    const float nw0 = F.gnorm_w()[2 * lane], nw1 = F.gnorm_w()[2 * lane + 1];
    for (int m = gw; m < MT; m += NGW) {
        float2 o[8]; unsigned zp[8];
#pragma unroll
        for (int h = 0; h < 8; ++h) { o[h] = *(const float2*)(F.OA() + (size_t)m * 1024 + h * 128 + 2 * lane); zp[h] = *(const unsigned*)(F.PROJ() + (size_t)m * NP + 3072 + h * 128 + 2 * lane); }
#pragma unroll
        for (int h = 0; h < 8; ++h) {
            const float rs = rsqrtf(wave_sum(o[h].x * o[h].x + o[h].y * o[h].y) * (1.f / 128.f) + RMS_EPS);
            *(unsigned*)(F.MIX() + (size_t)m * DM + h * 128 + 2 * lane) = pk2(o[h].x * rs * nw0 * silu_f(bflo(zp[h])), o[h].y * rs * nw1 * silu_f(bfhi(zp[h])));
        }
    }
}

template <int NSPLIT, bool RB> __device__ __forceinline__ void ln_load_row(f32x4 (&v)[8], int m, int lane, const float* Y, const float* part, const void* res_s) {
    if (m < MP) {
        const f32x4* yr = (const f32x4*)(Y + (size_t)m * DM);
#pragma unroll
        for (int j = 0; j < 8; ++j) v[j] = __builtin_nontemporal_load(yr + 64 * j + lane);
    } else {
#pragma unroll
        for (int j = 0; j < 8; ++j) {
            f32x4 p[NSPLIT];
#pragma unroll
            for (int sp = 0; sp < NSPLIT; ++sp) p[sp] = ((const f32x4*)(part + ((size_t)sp * 512 + (m - MP)) * DM))[64 * j + lane];
            f32x4 a;
            if (RB) { const u32x2 w = ((const u32x2*)((const bf16_t*)res_s + (size_t)(m - MP) * DM))[64 * j + lane]; const unsigned wx = w.x, wy = w.y; a[0] = bflo(wx); a[1] = bfhi(wx); a[2] = bflo(wy); a[3] = bfhi(wy); }
            else a = ((const f32x4*)((const float*)res_s + (size_t)(m - MP) * DM))[64 * j + lane];
            a = a * ALPHA;
#pragma unroll
            for (int sp = 0; sp < NSPLIT; ++sp) a += p[sp];
            v[j] = a;
        }
    }
}
__device__ __forceinline__ int ln_row_of(int gw, int NGW, int i) {
    if (NGW == 2048) {
        if (gw < 512) return i == 0 ? MP + gw : (i == 1 ? 7680 + gw : -1);
        return i < 5 ? (gw - 512) + 1536 * i : -1;
    }
    const int m = gw + i * NGW; return m < MT ? m : -1;
}
template <int NSPLIT, bool RB> __device__ __forceinline__ void ln_rows(Ctx& F, const float* Y, const float* gam, const float* bet, float* o32, bf16_t* o16, const float* part, const void* res_s) {
    const int gw = blockIdx.x * 8 + F.wave(), NGW = F.G_() * 8, lane = F.lane();
    f32x4 nv[8];
    int m = ln_row_of(gw, NGW, 0);
    if (m >= 0) ln_load_row<NSPLIT, RB>(nv, m, lane, Y, part, res_s);
    for (int i = 0; m >= 0; ++i) {
        f32x4 v[8]; float s = 0.f;
#pragma unroll
        for (int j = 0; j < 8; ++j) { v[j] = nv[j]; s += (v[j][0] + v[j][1]) + (v[j][2] + v[j][3]); }
        const int mn = ln_row_of(gw, NGW, i + 1);
        if (mn >= 0) ln_load_row<NSPLIT, RB>(nv, mn, lane, Y, part, res_s);
        const float mean = wave_sum(s) * (1.f / DM); float s2 = 0.f;
#pragma unroll
        for (int j = 0; j < 8; ++j) { v[j] = v[j] - mean; s2 += (v[j][0] * v[j][0] + v[j][1] * v[j][1]) + (v[j][2] * v[j][2] + v[j][3] * v[j][3]); }
        const float rstd = rsqrtf(wave_sum(s2) * (1.f / DM) + LN_EPS);
#pragma unroll
        for (int j = 0; j < 8; ++j) {
            const f32x4 gg = ((const f32x4*)gam)[64 * j + lane], bb = ((const f32x4*)bet)[64 * j + lane];
            const f32x4 o = v[j] * rstd * gg + bb;
            if (o32) __builtin_nontemporal_store(o, (f32x4*)(o32 + (size_t)m * DM) + 64 * j + lane);
            if (o16) { u32x2 w; w.x = pk2(o[0], o[1]); w.y = pk2(o[2], o[3]); __builtin_nontemporal_store(w, (u32x2*)(o16 + (size_t)m * DM + 256 * j + 4 * lane)); }
        }
        m = mn;
    }
}

#define XB_TMO      128
#define XB_XCNT(j)  (256  + 64 * (j))
#define XB_XSUB(j)  (1280 + 64 * (j))
#define XB_XGEN(j)  (2304 + 64 * (j))
#define XB_TOP      3328
#define XB_TOPGEN   3392
#define XCD_BAR_WORDS 3456
#define XB_SPIN_CAP (1u << 18)

__device__ __forceinline__ unsigned xb_ld(unsigned* p)              { return __hip_atomic_load(p, __ATOMIC_RELAXED, __HIP_MEMORY_SCOPE_AGENT); }
__device__ __forceinline__ unsigned xb_add(unsigned* p, unsigned v) { return __hip_atomic_fetch_add(p, v, __ATOMIC_RELAXED, __HIP_MEMORY_SCOPE_AGENT); }
__device__ __forceinline__ unsigned xb_xcc_id() { return (unsigned)__builtin_amdgcn_s_getreg((3 << 11) | 20) & 0xFu; }
#define XB_SPIN(cond, bar) do { unsigned _sp = 0; while (cond) { __builtin_amdgcn_s_sleep(1); \
    if ((++_sp & 255u) == 0u) { if (xb_ld(&(bar)[XB_TMO])) break; if (_sp > XB_SPIN_CAP) { atomicAdd(&(bar)[XB_TMO], 1u); break; } } } } while (0)

struct XcdBarrier {
    unsigned* bar; unsigned x;
    volatile LAS unsigned* st;
};

__device__ __forceinline__ XcdBarrier xcd_barrier_post(unsigned* bar, volatile LAS unsigned* st) {
    XcdBarrier b; b.bar = bar; b.x = xb_xcc_id(); b.st = st;
    if (threadIdx.x == 0) (void)xb_add(&bar[XB_XCNT(b.x)], 1u);
    return b;
}
__device__ __forceinline__ void xcd_barrier_complete(unsigned* bar, unsigned x, unsigned& nloc, unsigned& nx) {
    const unsigned G = gridDim.x * gridDim.y * gridDim.z;
    unsigned sum, cnt, mine, sp = 0u;
    for (;;) {
        sum = 0u; cnt = 0u; mine = 0u;
#pragma unroll
        for (unsigned j = 0; j < 16; ++j) { const unsigned c = xb_ld(&bar[XB_XCNT(j)]); sum += c; cnt += (c > 0u) ? 1u : 0u; mine = (j == x) ? c : mine; }
        if (sum == G) break;
        __builtin_amdgcn_s_sleep(1);
        if ((++sp & 255u) == 0u) { if (xb_ld(&bar[XB_TMO])) break; if (sp > XB_SPIN_CAP) { atomicAdd(&bar[XB_TMO], 1u); break; } }
    }
    nloc = mine > 0u ? mine : 1u; nx = cnt > 0u ? cnt : 1u;
}

__device__ __forceinline__ void xcd_barrier(const XcdBarrier& b) {
    asm volatile("s_waitcnt vmcnt(0)" ::: "memory");
    __syncthreads();
    if (threadIdx.x == 0) {
        unsigned* bar = b.bar;
        __builtin_amdgcn_s_waitcnt(0);
        unsigned nloc = b.st[0], nx = b.st[1];
        if (nloc == 0u) { xcd_barrier_complete(bar, b.x, nloc, nx); b.st[0] = nloc; b.st[1] = nx; }
        const unsigned old = xb_add(&bar[XB_XSUB(b.x)], 1u);
        const unsigned gen = old / nloc;
        if (old + 1u == (gen + 1u) * nloc) {
            __builtin_amdgcn_fence(__ATOMIC_RELEASE, "agent");
            asm volatile("s_waitcnt vmcnt(0)" ::: "memory");
            const unsigned og = xb_add(&bar[XB_TOP], 1u);
            const unsigned tg = og / nx;
            if (og + 1u == (tg + 1u) * nx) xb_add(&bar[XB_TOPGEN], 1u);
            else XB_SPIN(xb_ld(&bar[XB_TOPGEN]) == tg, bar);
            __builtin_amdgcn_fence(__ATOMIC_ACQUIRE, "agent");
            xb_add(&bar[XB_XGEN(b.x)], 1u);
            asm volatile("s_waitcnt vmcnt(0)" ::: "memory");
        } else {
            XB_SPIN(xb_ld(&bar[XB_XGEN(b.x)]) == gen, bar);
            __builtin_amdgcn_fence(__ATOMIC_ACQUIRE, "agent");
            asm volatile("s_waitcnt vmcnt(0)" ::: "memory");
        }
    }
    __syncthreads();
}

struct Args { const float* in[18]; float* out; unsigned char* ws; int ph_lo, ph_hi; };
__global__ void __launch_bounds__(512, 2) mk_fwd(Args args) {
    extern __shared__ __attribute__((aligned(16))) unsigned char lds[];
    cg::grid_group grid = cg::this_grid();
    Ctx F;
    F.kp = (kptr_t)__builtin_amdgcn_kernarg_segment_ptr();
    F.lds = lds;
    const int lo = args.ph_lo, hi = args.ph_hi;
    volatile LAS unsigned* misc = (volatile LAS unsigned*)(lds + LDS_BYTES - 128);
    if (threadIdx.x < 2) misc[threadIdx.x] = 0u;
    __syncthreads();
    XcdBarrier bar = xcd_barrier_post(F.ctl() + 4096, misc);
#define IN(k) (lo <= (k) && (k) < hi)
#define SEAM(k) do { if (IN(k) && IN((k) + 1)) { xcd_barrier(bar); } } while (0)
    LAS unsigned char* ldsl = (LAS unsigned char*)lds;

    if (lo > hi) grid.sync();
    if (IN(0)) p0_prologue(F);
    SEAM(0);
    if (IN(1)) {
        pg8::Gemm g{F.XB(), F.WinT(), MT, NP, DM}; pg8::StaticOrder S; S.init(MT, NP, F.G_(), (int)blockIdx.x, DM);
        pg8::EpiProj E{F.PROJ(), F.out(), OUT_CONVP, OUT_KP, OUT_VP, OUT_CONVS, OUT_KS, OUT_VS};
        pg8::gemm_phase<pg8::EpiProj, pg8::StaticOrder, true, true>(ldsl, g, S, E);
        if (F.G_() == 256 && blockIdx.x >= 184) {
            for (int j = 0; j < 6; ++j) p0_transpose_any(F, NT_EARLY + ((int)blockIdx.x - 184) * 48 + j * 8 + F.wave(), (float*)(F.lds + F.wave() * 16640));
        }
    }
    SEAM(1);
    if (IN(2)) p2_prep(F);
    SEAM(2);
    if (IN(3)) p3_mix(F);
    SEAM(3);
    if (IN(4)) p4_finalize(F);
    SEAM(4);
    if (IN(5)) {
        pg8::Gemm g{F.MIX(), F.WoutT(), MT, DM, DM}; pg8::SplitOrder S; S.init(MP, MT, DM, DM, NSPLIT1, F.G_(), (int)blockIdx.x);
        pg8::EpiRes<true> E{F.XB(), F.XB(), MT, F.Y1(), DM, ALPHA, F.PART1()};
        pg8::gemm_phase<pg8::EpiRes<true>, pg8::SplitOrder, true, true>(ldsl, g, S, E);
    }
    SEAM(5);
    if (IN(6)) ln_rows<NSPLIT1, false>(F, F.Y1(), F.ln1_g(), F.ln1_b(), nullptr, F.XB(), F.PART1(), F.x_sample());
    SEAM(6);
    if (IN(7)) {
        pg8::Gemm g{F.XB(), F.WupT(), MT, FF, DM}; pg8::StaticOrder S; S.init(MT, FF, F.G_(), (int)blockIdx.x, DM);
        pg8::EpiUp E{F.HB(), FF};
        pg8::gemm_phase<pg8::EpiUp, pg8::StaticOrder, true, true>(ldsl, g, S, E);
        if (F.G_() == 256 && blockIdx.x >= 64) {
            for (int idx = ((int)blockIdx.x - 64) * 8 + F.wave(); idx < I_DN; idx += 192 * 8) p0_transpose_any(F, NT_EARLY + I_OUT + I_UP + idx, (float*)(F.lds + F.wave() * 16640));
        }
    }
    SEAM(7);
    if (IN(8)) {
        pg8::Gemm g{F.HB(), F.WdnT(), MT, DM, FF}; pg8::SplitOrder S; S.init(MP, MT, DM, FF, NSPLIT2, F.G_(), (int)blockIdx.x);
        pg8::EpiRes<true> E{F.XB(), F.XB(), MT, F.Y2(), DM, ALPHA, F.PART2()};
        pg8::gemm_phase<pg8::EpiRes<true>, pg8::SplitOrder, true, true>(ldsl, g, S, E);
    }
    SEAM(8);
    if (IN(9)) ln_rows<NSPLIT2, true>(F, F.Y2(), F.ln2_g(), F.ln2_b(), F.out() + OUT_YP, nullptr, F.PART2(), F.XB() + (size_t)MP * DM);
#undef IN
#undef SEAM
}

extern "C" void kernel_launch(void* const* d_in, const int* in_sizes, int n_in, void* d_out, int out_size, void* d_ws, size_t ws_size, hipStream_t stream) {
    static int grid = 0;
    if (grid == 0) {
        if (n_in != 18 || (size_t)out_size != OUT_END || ws_size < WS_END) { fprintf(stderr, "kernel_launch: unexpected shapes: n_in %d out %d ws %zu (need %zu)\n", n_in, out_size, ws_size, (size_t)WS_END); grid = -1; return; }
        int dev = 0, cus = 0, per_cu = 0;
        hipGetDevice(&dev); hipDeviceGetAttribute(&cus, hipDeviceAttributeMultiprocessorCount, dev);
        if (hipFuncSetAttribute((const void*)mk_fwd, hipFuncAttributeMaxDynamicSharedMemorySize, LDS_BYTES) != hipSuccess) { fprintf(stderr, "kernel_launch: hipFuncSetAttribute failed\n"); grid = -1; return; }
        if (hipOccupancyMaxActiveBlocksPerMultiprocessor(&per_cu, (const void*)mk_fwd, 512, LDS_BYTES) != hipSuccess || per_cu < 1) { fprintf(stderr, "kernel_launch: occupancy query says %d\n", per_cu); per_cu = 1; }
        (void)hipGetLastError();
        grid = cus * (per_cu > 1 ? 1 : per_cu);
        if (grid <= 0) grid = 256;
    }
    if (grid < 0) return;
    hipMemsetAsync((char*)d_ws + WS_CTL, 0, 65536, stream);
    Args a{};
    for (int i = 0; i < 18; ++i) a.in[i] = (const float*)d_in[i];
    a.out = (float*)d_out; a.ws = (unsigned char*)d_ws;
    void* kargs[] = {&a};
#if MK_N_LAUNCHES == 1
    a.ph_lo = 0; a.ph_hi = NPHASE;
    hipError_t e = hipLaunchCooperativeKernel((const void*)mk_fwd, dim3(grid), dim3(512), kargs, LDS_BYTES, stream);
    if (e != hipSuccess) fprintf(stderr, "cooperative launch failed: %s (grid %d)\n", hipGetErrorString(e), grid);
#else
    for (int p = 0; p < NPHASE; ++p) {
        a.ph_lo = p; a.ph_hi = p + 1;
        hipError_t e = hipLaunchCooperativeKernel((const void*)mk_fwd, dim3(grid), dim3(512), kargs, LDS_BYTES, stream);
        if (e != hipSuccess) { fprintf(stderr, "cooperative launch %d failed: %s (grid %d)\n", p, hipGetErrorString(e), grid); break; }
    }
#endif
}
```

```cpp
#include <hip/hip_runtime.h>
#include <hip/hip_cooperative_groups.h>
#include <cstdio>
#include <cstdint>
namespace cg = cooperative_groups;

#ifndef MK_N_LAUNCHES
#define MK_N_LAUNCHES 1
#endif

namespace pg8 {
#define PG8_LAS __attribute__((address_space(3)))
typedef unsigned short bf16_t;
typedef short bf16x8 __attribute__((ext_vector_type(8)));
typedef float f32x4 __attribute__((ext_vector_type(4)));
typedef unsigned u32x4 __attribute__((ext_vector_type(4)));
constexpr int BM = 256, BK = 64, HALF = 128, HTB = HALF * BK * 2  , STAGE_BYTES = 8 * HTB, NXCD = 8, WGM = 8;

__host__ __device__ __forceinline__ int lds_byte(int r, int c) { const int st = (r >> 4) * 2 + (c >> 5), rr = r & 15, cc = c & 31, ob = rr * 64 + cc * 2; return st * 1024 + (ob ^ (((ob >> 9) & 1) << 5)); }
__host__ __device__ __forceinline__ void stage_rc(int b, int& R, int& C) { const int st = b / 1024, sb = b % 1024, swz = sb ^ (((sb >> 9) & 1) << 5); R = (st >> 1) * 16 + swz / 64; C = (st & 1) * 32 + (swz % 64) / 2; }
__host__ __device__ __forceinline__ int perm32(int rho) { const int n = rho >> 4, i = rho & 15; return 8 * (i >> 2) + 4 * n + (i & 3); }

struct Unit { int pm, pn, k0, nt, split; };
struct Gemm { const bf16_t* A; const bf16_t* Bt; int M, N, K; };

struct StaticOrder {
    int nM, nN, nwg, G, c, ntk;
    __host__ __device__ void init(int M, int N, int G_, int c_, int K) { nM = M / BM; nN = N / BM; nwg = nM * nN; G = G_; c = c_; ntk = K / BK; }
    __host__ __device__ bool next(int i, Unit& u) const {
        const long L = (long)i * G + c; if (L >= nwg) return false;
        int wgid = (int)L; { const int q = nwg / NXCD, r = nwg % NXCD, xcd = wgid % NXCD, off = wgid / NXCD; wgid = (xcd < r ? xcd * (q + 1) : r * (q + 1) + (xcd - r) * q) + off; }
        const int nig = WGM * nN, gid = wgid / nig, fm = gid * WGM, gsz = (nM - fm) < WGM ? (nM - fm) : WGM;
        u.pm = fm + ((wgid % nig) % gsz); u.pn = (wgid % nig) / gsz; u.k0 = 0; u.nt = ntk; u.split = -1; return true;
    }
    __device__ __forceinline__ void a_ready(const Unit&) const {}
    __device__ __forceinline__ void done(const Unit&) const {}
};
struct SplitOrder {
    StaticOrder S; int nmain, nN, nMm, nsplit, ntk, G, c, ntail;
    __host__ __device__ void init(int Mmain, int Mtot, int N, int K, int nsplit_, int G_, int c_) {
        S.init(Mmain, N, G_, c_, K); G = G_; c = c_; nN = N / BM; nMm = Mmain / BM; nsplit = nsplit_; ntk = K / BK / nsplit_;
        nmain = (S.nwg > c_) ? (S.nwg - c_ + G_ - 1) / G_ : 0;
        ntail = (Mtot - Mmain) / BM * nN * nsplit_;
    }
    __host__ __device__ bool next(int i, Unit& u) const {
        if (i < nmain) return S.next(i, u);
        const long sub = (long)(i - nmain) * G + c; if (sub >= ntail) return false;
        const int tile = (int)sub / nsplit, ks = (int)sub % nsplit;
        u.pm = nMm + tile / nN; u.pn = tile % nN; u.k0 = ks * ntk; u.nt = ntk; u.split = ks; return true;
    }
    __device__ __forceinline__ void a_ready(const Unit&) const {}
    __device__ __forceinline__ void done(const Unit&) const {}
};

__device__ __forceinline__ unsigned cvt_pk_bf16(float lo, float hi) { unsigned r; asm volatile("v_cvt_pk_bf16_f32 %0, %1, %2" : "=v"(r) : "v"(lo), "v"(hi)); return r; }
typedef float f32x2 __attribute__((ext_vector_type(2)));
typedef unsigned u32x2 __attribute__((ext_vector_type(2)));
struct EpiProj {
    static constexpr bool PERM = true, AFTER_DRAIN = false;
    bf16_t* O; float* outp;
    size_t off_convp, off_kp, off_vp, off_convs, off_ks, off_vs;
    __device__ __forceinline__ void operator()(const f32x4 (&acc)[2][2][4][2], const Unit& u, int wr, int wc, int fr, int fq) const {
        const int row0 = u.pm * BM + wr * 64 + fr; const int colt = u.pn * BM; const int col0 = colt + wc * 32 + 8 * fq;
        const bool is_k = (colt >= 5120 && colt < 6144), is_v = (colt >= 6144), is_conv = (colt < 3072), samp = (u.pm >= 32);
#pragma unroll
        for (int ai = 0; ai < 2; ++ai)
#pragma unroll
            for (int m = 0; m < 4; ++m) {
                const int row = row0 + ai * HALF + m * 16;
                bf16_t* rowp = O + (size_t)row * 7168 + col0;
#pragma unroll
                for (int bj = 0; bj < 2; ++bj) {
                    const f32x4 v0 = acc[ai][bj][m][0], v1 = acc[ai][bj][m][1];
                    u32x4 w; w.x = cvt_pk_bf16(v0[0], v0[1]); w.y = cvt_pk_bf16(v0[2], v0[3]); w.z = cvt_pk_bf16(v1[0], v1[1]); w.w = cvt_pk_bf16(v1[2], v1[3]);
                    *(u32x4*)(rowp + bj * HALF) = w;
                    const int col = col0 + bj * HALF;
                    if (is_k || is_v) {
                        float* dst = outp + (samp ? (is_k ? off_ks : off_vs) + (size_t)(row - 8192) * 1024 : (is_k ? off_kp : off_vp) + (size_t)row * 1024) + (col - (is_k ? 5120 : 6144));
                        *(f32x4*)dst = v0; *(f32x4*)(dst + 4) = v1;
                    }
                    if (is_conv) {
                        if (!samp) { const int t = row & 2047; if (t >= 2045) { float* dst = outp + off_convp + (size_t)((row >> 11) * 3 + (t - 2045)) * 3072 + col; *(f32x4*)dst = v0; *(f32x4*)(dst + 4) = v1; } }
                        else { const int rs = row - 8192, t = rs & 31; if (t >= 29) { float* dst = outp + off_convs + (size_t)((rs >> 5) * 3 + (t - 29)) * 3072 + col; *(f32x4*)dst = v0; *(f32x4*)(dst + 4) = v1; } }
                    }
                }
            }
    }
};
struct EpiUp {
    static constexpr bool PERM = true, AFTER_DRAIN = false;
    bf16_t* O; int ldc;
    __device__ __forceinline__ void operator()(const f32x4 (&acc)[2][2][4][2], const Unit& u, int wr, int wc, int fr, int fq) const {
        const int row0 = u.pm * BM + wr * 64 + fr; const int col0 = u.pn * BM + wc * 32 + 8 * fq;
#pragma unroll
        for (int ai = 0; ai < 2; ++ai)
#pragma unroll
            for (int m = 0; m < 4; ++m) {
                bf16_t* rowp = O + (size_t)(row0 + ai * HALF + m * 16) * ldc + col0;
#pragma unroll
                for (int bj = 0; bj < 2; ++bj) {
                    f32x4 v0 = acc[ai][bj][m][0], v1 = acc[ai][bj][m][1];
#pragma unroll
                    for (int e = 0; e < 4; ++e) { const float a = fmaxf(v0[e], 0.f), b = fmaxf(v1[e], 0.f); v0[e] = a * a; v1[e] = b * b; }
                    u32x4 w; w.x = cvt_pk_bf16(v0[0], v0[1]); w.y = cvt_pk_bf16(v0[2], v0[3]); w.z = cvt_pk_bf16(v1[0], v1[1]); w.w = cvt_pk_bf16(v1[2], v1[3]);
                    *(u32x4*)(rowp + bj * HALF) = w;
                }
            }
    }
};
template <bool RB> struct EpiRes {
    static constexpr bool PERM = false, AFTER_DRAIN = false;
    const void* res0; const void* res1; int split; float* out; int ldc; float alpha; float* part;
    __device__ __forceinline__ void operator()(const f32x4 (&acc)[2][2][4][2], const Unit& u, int wr, int wc, int fr, int fq) const {
        const int col0 = u.pn * BM + wc * 32 + 4 * fq;
        if (u.split >= 0) {
#pragma unroll
            for (int ai = 0; ai < 2; ++ai)
#pragma unroll
                for (int m = 0; m < 4; ++m) {
                    const int row = u.pm * BM + ai * HALF + wr * 64 + m * 16 + fr;
                    bf16_t* op = (bf16_t*)part + ((size_t)u.split * 512 + (row - 8192)) * ldc + col0;
#pragma unroll
                    for (int bj = 0; bj < 2; ++bj)
#pragma unroll
                        for (int n = 0; n < 2; ++n) { const f32x4 a = acc[ai][bj][m][n]; u32x2 w2; w2.x = cvt_pk_bf16(a[0], a[1]); w2.y = cvt_pk_bf16(a[2], a[3]); *(u32x2*)(op + bj * HALF + n * 16) = w2; }
                }
            return;
        }
#pragma unroll
        for (int ai = 0; ai < 2; ++ai) {
            f32x4 r[4][2][2];
#pragma unroll
            for (int m = 0; m < 4; ++m) {
                const int row = u.pm * BM + ai * HALF + wr * 64 + m * 16 + fr;
                const size_t roff = (row < split ? (size_t)row : (size_t)(row - split)) * ldc + col0;
                const void* rb = row < split ? res0 : res1;
#pragma unroll
                for (int bj = 0; bj < 2; ++bj)
#pragma unroll
                    for (int n = 0; n < 2; ++n) {
                        if (RB) { const u32x2 w = *(const u32x2*)((const bf16_t*)rb + roff + bj * HALF + n * 16); const unsigned wx = w.x, wy = w.y;
                                  r[m][bj][n][0] = __builtin_bit_cast(float, wx << 16); r[m][bj][n][1] = __builtin_bit_cast(float, wx & 0xffff0000u); r[m][bj][n][2] = __builtin_bit_cast(float, wy << 16); r[m][bj][n][3] = __builtin_bit_cast(float, wy & 0xffff0000u); }
                        else r[m][bj][n] = *(const f32x4*)((const float*)rb + roff + bj * HALF + n * 16);
                    }
            }
#pragma unroll
            for (int m = 0; m < 4; ++m) {
                const int row = u.pm * BM + ai * HALF + wr * 64 + m * 16 + fr;
                float* op = out + (size_t)row * ldc + col0;
#pragma unroll
                for (int bj = 0; bj < 2; ++bj)
#pragma unroll
                    for (int n = 0; n < 2; ++n) *(f32x4*)(op + bj * HALF + n * 16) = r[m][bj][n] * alpha + acc[ai][bj][m][n];
            }
        }
    }
};

template <class Epi, class Sched, bool ALIGN_EPI = false, bool SP2 = false>
__device__ __forceinline__ void gemm_phase(PG8_LAS unsigned char* lds, const Gemm g, const Sched& S, const Epi& E) {
    const int tid = threadIdx.x, wid = __builtin_amdgcn_readfirstlane(tid >> 6), lane = tid & 63, wr = wid >> 2, wc = wid & 3, fr = lane & 15, fq = lane >> 4;
    const int K = g.K;
    unsigned voffA[2], voffB[2];
#pragma unroll
    for (int i = 0; i < 2; ++i) { int R, C; stage_rc(tid * 16 + i * 8192, R, C); const int Rb = Epi::PERM ? ((R & ~31) + perm32(R & 31)) : R;
        voffA[i] = (unsigned)(R * K + C) * 2u; voffB[i] = (unsigned)(Rb * K + C) * 2u; }
    const size_t kstep = (size_t)(BK * 2);
    const size_t hstep = (size_t)HALF * K * 2;
    const size_t tstep = 2 * hstep;
    const unsigned ldsw = (unsigned)wid * 1024u;
    const int aoff = lds_byte(wr * 64 + fr, fq * 8), boff = lds_byte(wc * 32 + fr, fq * 8);
#define PG8_SA(b, h) (((b) * 2 + (h)) * HTB)
#define PG8_SB(b, h) ((4 + (b) * 2 + (h)) * HTB)
#define PG8_STAGE(bufoff, gbase, voff) do { _Pragma("unroll") for (int _i = 0; _i < 2; ++_i) \
        __builtin_amdgcn_global_load_lds((const unsigned*)((const char*)(gbase) + (voff)[_i]), (PG8_LAS unsigned*)(lds + (bufoff) + ldsw + _i * 8192), 16, 0, 0); } while (0)
#define PG8_LDA(dst, b, h) do { _Pragma("unroll") for (int m = 0; m < 4; ++m) _Pragma("unroll") for (int k = 0; k < 2; ++k) dst[m][k] = *(const PG8_LAS bf16x8*)(lds + PG8_SA(b, h) + aoff + m * 2048 + k * 1024); } while (0)
#define PG8_LDB(dst, b, h) do { _Pragma("unroll") for (int n = 0; n < 2; ++n) _Pragma("unroll") for (int k = 0; k < 2; ++k) dst[n][k] = *(const PG8_LAS bf16x8*)(lds + PG8_SB(b, h) + boff + n * 2048 + k * 1024); } while (0)
#define PG8_MMA(ai, bj, At, Bt) do { __builtin_amdgcn_s_setprio(1); _Pragma("unroll") for (int m = 0; m < 4; ++m) _Pragma("unroll") for (int n = 0; n < 2; ++n) _Pragma("unroll") for (int k = 0; k < 2; ++k) \
        acc[ai][bj][m][n] = __builtin_amdgcn_mfma_f32_16x16x32_bf16(Bt[n][k], At[m][k], acc[ai][bj][m][n], 0, 0, 0); __builtin_amdgcn_s_setprio(0); } while (0)
#define PG8_WAIT_V(n) asm volatile("s_waitcnt vmcnt(" #n ")" ::: "memory")
#define PG8_WAIT_L(n) asm volatile("s_waitcnt lgkmcnt(" #n ")" ::: "memory")
#define PG8_BAR __builtin_amdgcn_s_barrier()
#define PG8_SCHED __builtin_amdgcn_sched_barrier(0)
    Unit cur, nxt; int ui = 0;
    if (!S.next(0, cur)) return;
    f32x4 acc[2][2][4][2];
#pragma unroll
    for (int a = 0; a < 2; ++a)
#pragma unroll
        for (int b = 0; b < 2; ++b)
#pragma unroll
            for (int m = 0; m < 4; ++m)
#pragma unroll
                for (int n = 0; n < 2; ++n) acc[a][b][m][n] = (f32x4){0.f, 0.f, 0.f, 0.f};
    bf16x8 At[4][2], B0[2][2], B1[2][2];
    const char* cA = (const char*)g.A + (size_t)cur.pm * tstep + (size_t)cur.k0 * kstep; const char* cB = (const char*)g.Bt + (size_t)cur.pn * tstep + (size_t)cur.k0 * kstep;
    S.a_ready(cur);
    if constexpr (SP2) {
        PG8_STAGE(PG8_SB(0, 0), cB, voffB); PG8_STAGE(PG8_SB(0, 1), cB + hstep, voffB); PG8_STAGE(PG8_SA(0, 0), cA, voffA); PG8_STAGE(PG8_SA(0, 1), cA + hstep, voffA);
        if (wr == 1) PG8_BAR;
        PG8_WAIT_V(2); PG8_BAR;
        PG8_STAGE(PG8_SB(1, 0), cB + kstep, voffB); PG8_STAGE(PG8_SA(1, 0), cA + kstep, voffA); PG8_STAGE(PG8_SB(1, 1), cB + hstep + kstep, voffB);
        PG8_WAIT_V(6); PG8_BAR;
    } else {
        PG8_STAGE(PG8_SB(0, 0), cB, voffB); PG8_STAGE(PG8_SA(0, 0), cA, voffA); PG8_STAGE(PG8_SB(0, 1), cB + hstep, voffB); PG8_STAGE(PG8_SA(0, 1), cA + hstep, voffA);
        if (wr == 1) PG8_BAR;
        PG8_WAIT_V(4); PG8_BAR;
        PG8_STAGE(PG8_SB(1, 0), cB + kstep, voffB); PG8_STAGE(PG8_SA(1, 0), cA + kstep, voffA); PG8_STAGE(PG8_SB(1, 1), cB + hstep + kstep, voffB);
        PG8_WAIT_V(6); PG8_BAR;
    }
    for (;;) {
        const bool has_next = S.next(ui + 1, nxt);
        const char* nA = has_next ? (const char*)g.A + (size_t)nxt.pm * tstep + (size_t)nxt.k0 * kstep : cA; const char* nB = has_next ? (const char*)g.Bt + (size_t)nxt.pn * tstep + (size_t)nxt.k0 * kstep : cB;
        const int nt = cur.nt;
        for (int t = 0; t < nt; t += 2) {
            const bool last = (t == nt - 2);
            const char* a1 = cA + (size_t)(t + 1) * kstep;
            const char* a2 = last ? nA : cA + (size_t)(t + 2) * kstep; const char* b2 = last ? nB : cB + (size_t)(t + 2) * kstep;
            const char* a3 = a2 + kstep; const char* b3 = b2 + kstep;
            if (last && has_next) S.a_ready(nxt);
            if constexpr (SP2) {
            PG8_LDB(B0, 0, 0); PG8_LDB(B1, 0, 1); PG8_SCHED; PG8_LDA(At, 0, 0); PG8_STAGE(PG8_SA(1, 1), a1 + hstep, voffA);
            PG8_WAIT_V(8); PG8_WAIT_L(0); PG8_BAR; PG8_MMA(0, 0, At, B0); PG8_MMA(0, 1, At, B1); PG8_BAR; PG8_SCHED;
            PG8_LDA(At, 0, 1); PG8_STAGE(PG8_SB(0, 0), b2, voffB); PG8_STAGE(PG8_SB(0, 1), b2 + hstep, voffB); PG8_STAGE(PG8_SA(0, 0), a2, voffA);
            PG8_WAIT_V(8); PG8_WAIT_L(0); PG8_BAR; PG8_MMA(1, 0, At, B0); PG8_MMA(1, 1, At, B1); PG8_BAR; PG8_SCHED;
            PG8_LDB(B0, 1, 0); PG8_LDB(B1, 1, 1); PG8_SCHED; PG8_LDA(At, 1, 0); PG8_STAGE(PG8_SA(0, 1), a2 + hstep, voffA);
            PG8_WAIT_V(8); PG8_WAIT_L(0); PG8_BAR; PG8_MMA(0, 0, At, B0); PG8_MMA(0, 1, At, B1); PG8_BAR; PG8_SCHED;
            PG8_LDA(At, 1, 1); PG8_STAGE(PG8_SB(1, 0), b3, voffB); PG8_STAGE(PG8_SB(1, 1), b3 + hstep, voffB); PG8_STAGE(PG8_SA(1, 0), a3, voffA);
            PG8_WAIT_V(8); PG8_WAIT_L(0); PG8_BAR; PG8_MMA(1, 0, At, B0); PG8_MMA(1, 1, At, B1); PG8_BAR; PG8_SCHED;
            } else {
            PG8_LDB(B0, 0, 0); PG8_SCHED; PG8_LDA(At, 0, 0); PG8_STAGE(PG8_SA(1, 1), a1 + hstep, voffA);
            PG8_WAIT_L(8); PG8_BAR; PG8_WAIT_L(0); PG8_MMA(0, 0, At, B0); PG8_BAR; PG8_SCHED;
            PG8_LDB(B1, 0, 1); PG8_STAGE(PG8_SB(0, 0), b2, voffB);
            PG8_BAR; PG8_WAIT_L(0); PG8_MMA(0, 1, At, B1); PG8_BAR;
            PG8_LDA(At, 0, 1); PG8_STAGE(PG8_SA(0, 0), a2, voffA);
            PG8_BAR; PG8_WAIT_L(0); PG8_MMA(1, 0, At, B0); PG8_BAR; PG8_SCHED;
            PG8_STAGE(PG8_SB(0, 1), b2 + hstep, voffB);
            PG8_WAIT_V(6); PG8_BAR; PG8_MMA(1, 1, At, B1); PG8_BAR;
            PG8_LDB(B0, 1, 0); PG8_SCHED; PG8_LDA(At, 1, 0); PG8_STAGE(PG8_SA(0, 1), a2 + hstep, voffA);
            PG8_WAIT_L(8); PG8_BAR; PG8_WAIT_L(0); PG8_MMA(0, 0, At, B0); PG8_BAR; PG8_SCHED;
            PG8_LDB(B1, 1, 1); PG8_STAGE(PG8_SB(1, 0), b3, voffB);
            PG8_BAR; PG8_WAIT_L(0); PG8_MMA(0, 1, At, B1); PG8_BAR;
            PG8_LDA(At, 1, 1); PG8_STAGE(PG8_SA(1, 0), a3, voffA);
            PG8_BAR; PG8_WAIT_L(0); PG8_MMA(1, 0, At, B0); PG8_BAR; PG8_SCHED;
            PG8_STAGE(PG8_SB(1, 1), b3 + hstep, voffB);
            PG8_WAIT_V(6); PG8_BAR; PG8_MMA(1, 1, At, B1); PG8_BAR;
            }
        }
        if constexpr (ALIGN_EPI) { if (wr == 0) PG8_BAR; }
        if constexpr (!Epi::AFTER_DRAIN) { E(acc, cur, wr, wc, fr, fq); S.done(cur); }
        if (!has_next) break;
#pragma unroll
        for (int a = 0; a < 2; ++a)
#pragma unroll
            for (int b = 0; b < 2; ++b)
#pragma unroll
                for (int m = 0; m < 4; ++m)
#pragma unroll
                    for (int n = 0; n < 2; ++n) acc[a][b][m][n] = (f32x4){0.f, 0.f, 0.f, 0.f};
        cur = nxt; cA = nA; cB = nB; ++ui;
        if constexpr (ALIGN_EPI) { if (wr == 1) PG8_BAR; }
    }
    PG8_WAIT_V(0);
    if constexpr (!ALIGN_EPI) { if (wr == 0) PG8_BAR; }
    PG8_BAR;
    if constexpr (Epi::AFTER_DRAIN) { E.fused(acc, cur, wr, wc, fr, fq, lds, wid, lane); S.done(cur); }
#undef PG8_SA
#undef PG8_SB
#undef PG8_STAGE
#undef PG8_LDA
#undef PG8_LDB
#undef PG8_MMA
#undef PG8_WAIT_V
#undef PG8_WAIT_L
#undef PG8_BAR
#undef PG8_SCHED
}
}

typedef unsigned short bf16_t;
typedef short bf16x8 __attribute__((ext_vector_type(8)));
typedef short bf16x4 __attribute__((ext_vector_type(4)));
typedef float f32x4 __attribute__((ext_vector_type(4)));
typedef unsigned u32x4 __attribute__((ext_vector_type(4)));
typedef unsigned u32x2 __attribute__((ext_vector_type(2)));
#define LAS __attribute__((address_space(3)))

constexpr int DM = 2048, MP = 8192, MS = 512, MT = 8704, NP = 7168, FF = 8192;
constexpr int NH = 8, HD = 128, SEQ = 2048, DSEQ = 32, PAST = 2048, NB = 4, NDB = 16;
constexpr int NCH_P = 1024, NCH = 1152;
constexpr float ALPHA = 1.189207115002721f;
constexpr float QSCALE = 0.08838834764831845f;
constexpr float LN_EPS = 1e-5f, RMS_EPS = 1e-6f, L2_EPS = 1e-6f;
constexpr int NPHASE = 10;

constexpr size_t OUT_YP = 0, OUT_YS = OUT_YP + (size_t)MP * DM, OUT_CONVP = OUT_YS + (size_t)MS * DM, OUT_SP = OUT_CONVP + (size_t)NB * 3 * 3072,
    OUT_KP = OUT_SP + (size_t)NB * NH * HD * HD, OUT_VP = OUT_KP + (size_t)MP * 1024, OUT_CONVS = OUT_VP + (size_t)MP * 1024, OUT_SS = OUT_CONVS + (size_t)NDB * 3 * 3072,
    OUT_KS = OUT_SS + (size_t)NDB * NH * HD * HD, OUT_VS = OUT_KS + (size_t)MS * 1024, OUT_END = OUT_VS + (size_t)MS * 1024;

constexpr size_t MiB = 1u << 20;
constexpr size_t WS_CTL = 0, CTL_BYTES = 1 * MiB;
constexpr size_t WS_WIN = 1 * MiB, WS_WOUT = 29 * MiB, WS_WUP = 37 * MiB, WS_WDN = 69 * MiB, WS_XB = 101 * MiB, WS_BA = 135 * MiB;
constexpr size_t WS_PROJ = 136 * MiB, WS_VT = 255 * MiB, WS_H = 136 * MiB;
constexpr size_t WS_U = 272 * MiB, WS_NW = 308 * MiB, WS_QD = 326 * MiB, WS_KTT = 344 * MiB, WS_ATT = 362 * MiB, WS_GT = 371 * MiB;
constexpr size_t WS_OA = 372 * MiB, WS_MIX = 406 * MiB, WS_PO = 440 * MiB, WS_PR = 450 * MiB, WS_END = 451 * MiB;
constexpr size_t WS_Y1 = 272 * MiB, WS_X1 = 340 * MiB, WS_Y2 = 272 * MiB;
constexpr size_t WS_PART1 = 136 * MiB, WS_PART2 = 1 * MiB;
constexpr int NSPLIT1 = 8, NSPLIT2 = 16;
constexpr int LDS_BYTES = 147456;

__device__ __forceinline__ unsigned f2bf(float f) { unsigned u = __builtin_bit_cast(unsigned, f); return (u + 0x7fffu + ((u >> 16) & 1u)) >> 16; }
__device__ __forceinline__ unsigned pk2(float lo, float hi) { unsigned r; asm volatile("v_cvt_pk_bf16_f32 %0, %1, %2" : "=v"(r) : "v"(lo), "v"(hi)); return r; }
__device__ __forceinline__ float asf(unsigned u) { return __builtin_bit_cast(float, u); }
__device__ __forceinline__ float bflo(unsigned p) { return __builtin_bit_cast(float, p << 16); }
__device__ __forceinline__ float bfhi(unsigned p) { return __builtin_bit_cast(float, p & 0xffff0000u); }
__device__ __forceinline__ f32x4 mfma16(bf16x8 a, bf16x8 b, f32x4 c) { return __builtin_amdgcn_mfma_f32_16x16x32_bf16(a, b, c, 0, 0, 0); }
__device__ __forceinline__ float wave_sum(float v) {
#pragma unroll
    for (int o = 1; o < 64; o <<= 1) v += __shfl_xor(v, o);
    return v;
}
__device__ __forceinline__ float silu_f(float x) { return x / (1.f + __expf(-x)); }
#define LDS_FENCE() asm volatile("s_waitcnt lgkmcnt(0)" ::: "memory")

typedef __attribute__((address_space(4))) const unsigned char* kptr_t;
struct Ctx {
    kptr_t kp; unsigned char* lds;
    __device__ __forceinline__ int tid() const { return (int)threadIdx.x; }
    __device__ __forceinline__ int lane() const { return (int)threadIdx.x & 63; }
    __device__ __forceinline__ int wave() const { return __builtin_amdgcn_readfirstlane((int)threadIdx.x >> 6); }
    __device__ __forceinline__ int G_() const { return (int)gridDim.x; }
    __device__ __forceinline__ const float* in(int i) const { return *(const float* const __attribute__((address_space(4)))*)(kp + 8 * i); }
    __device__ __forceinline__ float* out_() const { return *(float* const __attribute__((address_space(4)))*)(kp + 144); }
    __device__ __forceinline__ unsigned char* ws_() const { return *(unsigned char* const __attribute__((address_space(4)))*)(kp + 152); }
    __device__ __forceinline__ const float* x_prompt() const { return in(0); }
    __device__ __forceinline__ const float* x_sample() const { return in(1); }
    __device__ __forceinline__ const float* st_conv() const { return in(2); }
    __device__ __forceinline__ const float* st_S() const { return in(3); }
    __device__ __forceinline__ const float* ck() const { return in(4); }
    __device__ __forceinline__ const float* cv() const { return in(5); }
    __device__ __forceinline__ const float* w_in() const { return in(6); }
    __device__ __forceinline__ const float* conv_w() const { return in(7); }
    __device__ __forceinline__ const float* a_log() const { return in(8); }
    __device__ __forceinline__ const float* dt_bias() const { return in(9); }
    __device__ __forceinline__ const float* gnorm_w() const { return in(10); }
    __device__ __forceinline__ const float* w_out() const { return in(11); }
    __device__ __forceinline__ const float* ln1_g() const { return in(12); }
    __device__ __forceinline__ const float* ln1_b() const { return in(13); }
    __device__ __forceinline__ const float* w_up() const { return in(14); }
    __device__ __forceinline__ const float* w_down() const { return in(15); }
    __device__ __forceinline__ const float* ln2_g() const { return in(16); }
    __device__ __forceinline__ const float* ln2_b() const { return in(17); }
    __device__ __forceinline__ bf16_t* WinT() const { return (bf16_t*)(ws_() + WS_WIN); }
    __device__ __forceinline__ bf16_t* WoutT() const { return (bf16_t*)(ws_() + WS_WOUT); }
    __device__ __forceinline__ bf16_t* WupT() const { return (bf16_t*)(ws_() + WS_WUP); }
    __device__ __forceinline__ bf16_t* WdnT() const { return (bf16_t*)(ws_() + WS_WDN); }
    __device__ __forceinline__ bf16_t* XB() const { return (bf16_t*)(ws_() + WS_XB); }
    __device__ __forceinline__ bf16_t* PROJ() const { return (bf16_t*)(ws_() + WS_PROJ); }
    __device__ __forceinline__ bf16_t* VT() const { return (bf16_t*)(ws_() + WS_VT); }
    __device__ __forceinline__ bf16_t* HB() const { return (bf16_t*)(ws_() + WS_H); }
    __device__ __forceinline__ bf16_t* NW() const { return (bf16_t*)(ws_() + WS_NW); }
    __device__ __forceinline__ bf16_t* QD() const { return (bf16_t*)(ws_() + WS_QD); }
    __device__ __forceinline__ bf16_t* KTT() const { return (bf16_t*)(ws_() + WS_KTT); }
    __device__ __forceinline__ bf16_t* ATT() const { return (bf16_t*)(ws_() + WS_ATT); }
    __device__ __forceinline__ bf16_t* MIX() const { return (bf16_t*)(ws_() + WS_MIX); }
    __device__ __forceinline__ float* BA() const { return (float*)(ws_() + WS_BA); }
    __device__ __forceinline__ float* U() const { return (float*)(ws_() + WS_U); }
    __device__ __forceinline__ float* GT() const { return (float*)(ws_() + WS_GT); }
    __device__ __forceinline__ float* OA() const { return (float*)(ws_() + WS_OA); }
    __device__ __forceinline__ float* PO() const { return (float*)(ws_() + WS_PO); }
    __device__ __forceinline__ float* PR() const { return (float*)(ws_() + WS_PR); }
    __device__ __forceinline__ float* Y1() const { return (float*)(ws_() + WS_Y1); }
    __device__ __forceinline__ float* X1() const { return (float*)(ws_() + WS_X1); }
    __device__ __forceinline__ float* Y2() const { return (float*)(ws_() + WS_Y2); }
    __device__ __forceinline__ float* PART1() const { return (float*)(ws_() + WS_PART1); }
    __device__ __forceinline__ float* PART2() const { return (float*)(ws_() + WS_PART2); }
    __device__ __forceinline__ float* out() const { return out_(); }
    __device__ __forceinline__ unsigned* ctl() const { return (unsigned*)(ws_() + WS_CTL); }
};

__device__ __forceinline__ void p0_transpose_item(const float* W, int ldw, int nblk, int K, bf16_t* WT, int row_off, float* scr, int item, int lane) {
    const int kb = item / nblk, nb = item % nblk, k0 = 64 * kb, n0 = 64 * nb;
    const int ks = lane >> 4, nq = lane & 15;
    f32x4 v[16];
#pragma unroll
    for (int i = 0; i < 16; ++i) v[i] = *(const f32x4*)(W + (size_t)(k0 + 4 * i + ks) * ldw + n0 + 4 * nq);
#pragma unroll
    for (int i = 0; i < 16; ++i) { float* d = scr + (4 * i + ks) * 65 + 4 * nq; d[0] = v[i][0]; d[1] = v[i][1]; d[2] = v[i][2]; d[3] = v[i][3]; }
    LDS_FENCE();
    const int c = lane & 7;
#pragma unroll
    for (int j = 0; j < 8; ++j) { const int n = (lane >> 3) + 8 * j; const float* s = scr + (8 * c) * 65 + n;
        u32x4 o; o.x = pk2(s[0 * 65], s[1 * 65]); o.y = pk2(s[2 * 65], s[3 * 65]); o.z = pk2(s[4 * 65], s[5 * 65]); o.w = pk2(s[6 * 65], s[7 * 65]);
        *(u32x4*)(WT + (size_t)(row_off + n0 + n) * K + k0 + 8 * c) = o; }
    LDS_FENCE();
}
__device__ __forceinline__ void p0_load_x(f32x4 (&v)[8], Ctx& F, int m, int lane) {
    const float* xr = (m < MP) ? F.x_prompt() + (size_t)m * DM : F.x_sample() + (size_t)(m - MP) * DM;
#pragma unroll
    for (int j = 0; j < 8; ++j) v[j] = ((const f32x4*)xr)[64 * j + lane];
}
constexpr int I_IN1 = 32 * 64, I_IN2 = 32 * 48, I_OUT = 32 * 32, I_UP = 32 * 128, I_DN = 128 * 32;
constexpr int NT_EARLY = I_IN1 + I_IN2, NT_LATE = I_OUT + I_UP + I_DN;
__device__ __forceinline__ void p0_transpose_any(Ctx& F, int it, float* scr) {
    int r = it; const float* W; int ldw, nblk, K, roff; bf16_t* WT;
    if (r < I_IN1) { W = F.w_in(); ldw = 7184; nblk = 64; K = DM; WT = F.WinT(); roff = 0; }
    else if ((r -= I_IN1) < I_IN2) { W = F.w_in() + 4112; ldw = 7184; nblk = 48; K = DM; WT = F.WinT(); roff = 4096; }
    else if ((r -= I_IN2) < I_OUT) { W = F.w_out(); ldw = DM; nblk = 32; K = DM; WT = F.WoutT(); roff = 0; }
    else if ((r -= I_OUT) < I_UP) { W = F.w_up(); ldw = FF; nblk = 128; K = DM; WT = F.WupT(); roff = 0; }
    else { r -= I_UP; W = F.w_down(); ldw = DM; nblk = 32; K = FF; WT = F.WdnT(); roff = 0; }
    p0_transpose_item(W, ldw, nblk, K, WT, roff, scr, r, F.lane());
}
__device__ __forceinline__ void p0_prologue(Ctx& F) {
    float* scr = (float*)(F.lds + F.wave() * 16640);
    const int gw = blockIdx.x * 8 + F.wave(), NGW = F.G_() * 8;
    for (int it = gw; it < NT_EARLY; it += NGW) p0_transpose_any(F, it, scr);
    __syncthreads();
    float* wT = (float*)F.lds;
    for (int k = F.tid(); k < DM; k += 512) {
        const float* src = F.w_in() + (size_t)k * 7184 + 4096;
#pragma unroll
        for (int q = 0; q < 4; ++q) { const f32x4 v = *(const f32x4*)(src + 4 * q); wT[(4 * q + 0) * DM + k] = v[0]; wT[(4 * q + 1) * DM + k] = v[1]; wT[(4 * q + 2) * DM + k] = v[2]; wT[(4 * q + 3) * DM + k] = v[3]; }
    }
    __syncthreads();
    f32x4 nv[8];
    if (gw < MT) p0_load_x(nv, F, gw, F.lane());
    for (int m = gw; m < MT; m += NGW) {
        f32x4 v[8];
#pragma unroll
        for (int j = 0; j < 8; ++j) v[j] = nv[j];
        if (m + NGW < MT) p0_load_x(nv, F, m + NGW, F.lane());
        bf16_t* xb = F.XB() + (size_t)m * DM;
#pragma unroll
        for (int j = 0; j < 8; ++j) { u32x2 o; o.x = pk2(v[j][0], v[j][1]); o.y = pk2(v[j][2], v[j][3]); *(u32x2*)(xb + 256 * j + 4 * F.lane()) = o; }
        float mine = 0.f;
#pragma unroll
        for (int c = 0; c < 16; ++c) {
            float s = 0.f;
#pragma unroll
            for (int j = 0; j < 8; ++j) { const f32x4 w = *(const f32x4*)(wT + c * DM + 256 * j + 4 * F.lane()); s += v[j][0] * w[0] + v[j][1] * w[1] + v[j][2] * w[2] + v[j][3] * w[3]; }
            s = wave_sum(s);
            if (F.lane() == c) mine = s;
        }
        if (F.lane() < 16) F.BA()[(size_t)m * 16 + F.lane()] = mine;
    }
}

constexpr int PL_KN = 0, PL_QN = 17408, PL_VBT = 34816, PL_KBGT = 53248, PL_KTT = 71680, PL_MM = 90112, PL_TB = 107520, PL_SM = 116736;
template <int C> __device__ __forceinline__ void gdn_prep(Ctx& F, bool sample, int b, int h, int n, int chunk) {
    bf16_t* KN = (bf16_t*)(F.lds + PL_KN); bf16_t* QN = (bf16_t*)(F.lds + PL_QN); bf16_t* VBt = (bf16_t*)(F.lds + PL_VBT); bf16_t* KBGt = (bf16_t*)(F.lds + PL_KBGT);
    bf16_t* KTt = (bf16_t*)(F.lds + PL_KTT); float* MM = (float*)(F.lds + PL_MM); bf16_t* Tb = (bf16_t*)(F.lds + PL_TB);
    float* s_beta = (float*)(F.lds + PL_SM); float* s_gc = s_beta + 64; float* s_egc = s_beta + 128;
    const int lane = F.lane(), wave = F.wave(), tid = F.tid(), fr = lane & 15, g = lane >> 4;
    const int seqrow = sample ? MP + b * DSEQ : b * SEQ;
    const int tpos0 = n * C;
    const int m0 = seqrow + tpos0;
    if (wave == 0) {
        float beta = 0.f, gg = 0.f;
        if (lane < C) {
            const float bl = F.BA()[(size_t)(m0 + lane) * 16 + h], al = F.BA()[(size_t)(m0 + lane) * 16 + 8 + h];
            beta = 1.f / (1.f + expf(-bl));
            const float xx = al + F.dt_bias()[h];
            const float sp = xx > 20.f ? xx : log1pf(expf(xx));
            gg = -expf(F.a_log()[h]) * sp;
        }
        float gc = gg;
#pragma unroll
        for (int o = 1; o < 64; o <<= 1) { const float t = __shfl_up(gc, o); if (lane >= o) gc += t; }
        if (lane < C) { s_beta[lane] = beta; s_gc[lane] = gc; s_egc[lane] = expf(gc); }
    }
    __syncthreads();
    const float gcl = s_gc[C - 1];
    {
        constexpr int TPW = C / 8, NRW = TPW + 3;
        float u0[3][NRW], u1[3][NRW];
#pragma unroll
        for (int which = 0; which < 3; ++which) {
            const int col = which * 1024 + h * 128 + 2 * lane;
#pragma unroll
            for (int r = 0; r < NRW; ++r) {
                const int pos = tpos0 + TPW * wave - 3 + r;
                if (pos >= 0) { const unsigned pk = *(const unsigned*)(F.PROJ() + (size_t)(seqrow + pos) * NP + col); u0[which][r] = bflo(pk); u1[which][r] = bfhi(pk); }
                else if (sample) { const float* s = F.st_conv() + (size_t)(b * 3 + pos + 3) * 3072 + col; u0[which][r] = s[0]; u1[which][r] = s[1]; }
                else { u0[which][r] = 0.f; u1[which][r] = 0.f; }
            }
        }
#pragma unroll
        for (int which = 0; which < 3; ++which) {
            const int col = which * 1024 + h * 128 + 2 * lane;
            float cw0[4], cw1[4];
#pragma unroll
            for (int i = 0; i < 4; ++i) { cw0[i] = F.conv_w()[i * 3072 + col]; cw1[i] = F.conv_w()[i * 3072 + col + 1]; }
#pragma unroll
            for (int tt = 0; tt < TPW; ++tt) {
                const int t = TPW * wave + tt;
                float x0 = 0.f, x1 = 0.f;
#pragma unroll
                for (int i = 0; i < 4; ++i) { x0 += cw0[i] * u0[which][tt + i]; x1 += cw1[i] * u1[which][tt + i]; }
                x0 = silu_f(x0); x1 = silu_f(x1);
                const float bt = s_beta[t], egc = s_egc[t];
                if (which == 0) {
                    const float rs = rsqrtf(wave_sum(x0 * x0 + x1 * x1) + L2_EPS);
                    x0 *= rs; x1 *= rs;
                    *(unsigned*)(QN + t * 136 + 2 * lane) = pk2(x0, x1);
                    const float f = QSCALE * egc;
                    *(unsigned*)(F.QD() + (size_t)chunk * 8192 + t * 128 + 2 * lane) = pk2(x0 * f, x1 * f);
                } else if (which == 1) {
                    const float rs = rsqrtf(wave_sum(x0 * x0 + x1 * x1) + L2_EPS);
                    x0 *= rs; x1 *= rs;
                    *(unsigned*)(KN + t * 136 + 2 * lane) = pk2(x0, x1);
                    const float f = bt * egc, f2 = expf(gcl - s_gc[t]);
                    KBGt[(2 * lane) * 72 + t] = (bf16_t)f2bf(x0 * f); KBGt[(2 * lane + 1) * 72 + t] = (bf16_t)f2bf(x1 * f);
                    KTt[(2 * lane) * 72 + t] = (bf16_t)f2bf(x0 * f2); KTt[(2 * lane + 1) * 72 + t] = (bf16_t)f2bf(x1 * f2);
                } else {
                    VBt[(2 * lane) * 72 + t] = (bf16_t)f2bf(x0 * bt); VBt[(2 * lane + 1) * 72 + t] = (bf16_t)f2bf(x1 * bt);
                }
            }
        }
    }
    __syncthreads();
    constexpr int NT = C / 16;
    for (int tile = wave; tile < NT * NT; tile += 8) {
        const int it = tile / NT, jt = tile % NT;
        f32x4 akk = {0.f, 0.f, 0.f, 0.f}, aqk = {0.f, 0.f, 0.f, 0.f};
#pragma unroll
        for (int ks = 0; ks < 4; ++ks) {
            const bf16x8 ki = *(const bf16x8*)(KN + (16 * it + fr) * 136 + 32 * ks + 8 * g);
            const bf16x8 kj = *(const bf16x8*)(KN + (16 * jt + fr) * 136 + 32 * ks + 8 * g);
            const bf16x8 qi = *(const bf16x8*)(QN + (16 * it + fr) * 136 + 32 * ks + 8 * g);
            akk = mfma16(ki, kj, akk);
            aqk = mfma16(kj, qi, aqk);
        }
        {   const int j = 16 * jt + fr; const float gj = s_gc[j];
#pragma unroll
            for (int jj = 0; jj < 4; ++jj) { const int i = 16 * it + 4 * g + jj; MM[i * 68 + j] = (i > j) ? s_beta[i] * akk[jj] * __expf(s_gc[i] - gj) : 0.f; } }
        {   const int i = 16 * it + fr; const float gi = s_gc[i]; float v[4];
#pragma unroll
            for (int jj = 0; jj < 4; ++jj) { const int j = 16 * jt + 4 * g + jj; v[jj] = (i >= j) ? aqk[jj] * QSCALE * __expf(gi - s_gc[j]) : 0.f; }
            u32x2 o; o.x = pk2(v[0], v[1]); o.y = pk2(v[2], v[3]);
            *(u32x2*)(F.ATT() + (size_t)chunk * 4096 + i * C + 16 * jt + 4 * g) = o; }
    }
    __syncthreads();
    if (wave == 0) {
        float tc[C];
        const float* MMv = MM; asm volatile("" : "+v"(MMv));
#pragma unroll
        for (int i = 0; i < C; ++i) {
            float a0 = (i == lane) ? 1.f : 0.f, a1 = 0.f, a2 = 0.f, a3 = 0.f;
#pragma unroll
            for (int j4 = 0; j4 < i; j4 += 4) {
                const f32x4 mv = *(const f32x4*)(MMv + i * 68 + j4);
                a0 -= mv[0] * tc[j4];
                if (j4 + 1 < i) a1 -= mv[1] * tc[j4 + 1];
                if (j4 + 2 < i) a2 -= mv[2] * tc[j4 + 2];
                if (j4 + 3 < i) a3 -= mv[3] * tc[j4 + 3];
            }
            tc[i] = (a0 + a1) + (a2 + a3);
        }
        if (lane < C) {
#pragma unroll
            for (int i = 0; i < C; ++i) Tb[i * 72 + lane] = (bf16_t)f2bf(tc[i]);
        }
    }
    __syncthreads();
    for (int job = wave; job < 2 * 8 * NT; job += 8) {
        const int mat = job / (8 * NT), dt = (job / NT) % 8, it = job % NT;
        const bf16_t* X = mat ? KBGt : VBt;
        f32x4 acc = {0.f, 0.f, 0.f, 0.f};
#pragma unroll
        for (int ks = 0; ks < C / 32; ++ks) {
            const bf16x8 a = *(const bf16x8*)(X + (16 * dt + fr) * 72 + 32 * ks + 8 * g);
            const bf16x8 bb = *(const bf16x8*)(Tb + (16 * it + fr) * 72 + 32 * ks + 8 * g);
            acc = mfma16(a, bb, acc);
        }
        const int i = 16 * it + fr, d0 = 16 * dt + 4 * g;
        if (mat == 0) *(f32x4*)(F.U() + (size_t)chunk * 8192 + i * 128 + d0) = acc;
        else { u32x2 o; o.x = pk2(-acc[0], -acc[1]); o.y = pk2(-acc[2], -acc[3]); *(u32x2*)(F.NW() + (size_t)chunk * 8192 + i * 128 + d0) = o; }
    }
    for (int idx = tid; idx < 128 * (C / 8); idx += 512) {
        const int d = idx / (C / 8), c8 = idx % (C / 8);
        *(u32x4*)(F.KTT() + (size_t)chunk * 8192 + d * C + c8 * 8) = *(const u32x4*)(KTt + d * 72 + c8 * 8);
    }
    if (tid == 0) F.GT()[chunk * 32] = expf(gcl);
    __syncthreads();
}
__device__ __forceinline__ void vt_item(Ctx& F, int wi) {
    bf16_t* tile = (bf16_t*)(F.lds + F.wave() * 8448);
    const int m0 = 64 * (wi >> 4), f0 = 64 * (wi & 15), lane = F.lane();
#pragma unroll 8
    for (int r = 0; r < 64; ++r) tile[r * 66 + lane] = F.PROJ()[(size_t)(m0 + r) * NP + 6144 + f0 + lane];
    LDS_FENCE();
#pragma unroll 8
    for (int f = 0; f < 64; ++f) F.VT()[(size_t)(f0 + f) * MT + m0 + lane] = tile[lane * 66 + f];
    LDS_FENCE();
}
__device__ __forceinline__ void p2_prep(Ctx& F) {
    constexpr int N_VT = (MT / 64) * 16 / 8;
    for (int it = blockIdx.x; it < NCH + N_VT; it += F.G_()) {
        if (it < NCH_P) { const int b = it >> 8, h = (it >> 5) & 7, n = it & 31; gdn_prep<64>(F, false, b, h, n, it); }
        else if (it < NCH) { const int bh = it - NCH_P; gdn_prep<32>(F, true, bh >> 3, bh & 7, 0, it); }
        else { vt_item(F, (it - NCH) * 8 + F.wave()); __syncthreads(); }
    }
}

constexpr int SL_ST = 0, SL_VN = 8704;
template <int C> struct ScanOps { bf16x8 bw[4], bq[4], ba[C / 32], bk[2][C / 32]; f32x4 u; float gt; };
template <int C> __device__ __forceinline__ void scan_load(Ctx& F, ScanOps<C>& o, int chunk, bool act, int c, int sl, int mt, int nt0, int fr, int g) {
    const bf16_t* NWc = F.NW() + (size_t)chunk * 8192; const bf16_t* QDc = F.QD() + (size_t)chunk * 8192;
    const bf16_t* ATc = F.ATT() + (size_t)chunk * 4096; const bf16_t* KTc = F.KTT() + (size_t)chunk * 8192; const float* Uc = F.U() + (size_t)chunk * 8192;
    o.gt = F.GT()[chunk * 32];
    if (act) {
        o.u = *(const f32x4*)(Uc + c * 128 + 32 * sl + 16 * mt + 4 * g);
#pragma unroll
        for (int ks = 0; ks < 4; ++ks) { o.bw[ks] = *(const bf16x8*)(NWc + c * 128 + 32 * ks + 8 * g); o.bq[ks] = *(const bf16x8*)(QDc + c * 128 + 32 * ks + 8 * g); }
#pragma unroll
        for (int ks = 0; ks < C / 32; ++ks) o.ba[ks] = *(const bf16x8*)(ATc + c * C + 32 * ks + 8 * g);
    }
#pragma unroll
    for (int i = 0; i < 2; ++i)
#pragma unroll
        for (int ks = 0; ks < C / 32; ++ks) o.bk[i][ks] = *(const bf16x8*)(KTc + (16 * (nt0 + i) + fr) * C + 32 * ks + 8 * g);
}
template <int C> __device__ __forceinline__ void scan_step(Ctx& F, ScanOps<C>& o, bool reload, int cnext, f32x4 (&accS)[2], bf16_t* St, bf16_t* VNt, bool act, int c, int row, int h, int sl, int mt, int nt0, int fr, int g) {
    f32x4 accV = {0.f, 0.f, 0.f, 0.f}, accO = {0.f, 0.f, 0.f, 0.f};
    const float gt = o.gt;
    if (act) {
        accV = o.u;
#pragma unroll
        for (int ks = 0; ks < 4; ++ks) {
            const bf16x8 a = *(const bf16x8*)(St + (16 * mt + fr) * 136 + 32 * ks + 8 * g);
            accV = mfma16(a, o.bw[ks], accV);
            accO = mfma16(a, o.bq[ks], accO);
        }
        if (reload) {
            const bf16_t* NWc = F.NW() + (size_t)cnext * 8192; const bf16_t* QDc = F.QD() + (size_t)cnext * 8192;
            o.u = *(const f32x4*)(F.U() + (size_t)cnext * 8192 + c * 128 + 32 * sl + 16 * mt + 4 * g);
#pragma unroll
            for (int ks = 0; ks < 4; ++ks) { o.bw[ks] = *(const bf16x8*)(NWc + c * 128 + 32 * ks + 8 * g); o.bq[ks] = *(const bf16x8*)(QDc + c * 128 + 32 * ks + 8 * g); }
        }
#pragma unroll
        for (int jj = 0; jj < 4; ++jj) VNt[(16 * mt + 4 * g + jj) * 72 + c] = (bf16_t)f2bf(accV[jj]);
    }
    __syncthreads();
    if (act) {
#pragma unroll
        for (int ks = 0; ks < C / 32; ++ks) {
            const bf16x8 a = *(const bf16x8*)(VNt + (16 * mt + fr) * 72 + 32 * ks + 8 * g);
            accO = mfma16(a, o.ba[ks], accO);
        }
        if (reload) {
#pragma unroll
            for (int ks = 0; ks < C / 32; ++ks) o.ba[ks] = *(const bf16x8*)(F.ATT() + (size_t)cnext * 4096 + c * C + 32 * ks + 8 * g);
        }
        *(f32x4*)(F.OA() + (size_t)row * 1024 + h * 128 + 32 * sl + 16 * mt + 4 * g) = accO;
    }
#pragma unroll
    for (int i = 0; i < 2; ++i) {
        accS[i] = accS[i] * gt;
        const int d = 16 * (nt0 + i) + fr;
#pragma unroll
        for (int ks = 0; ks < C / 32; ++ks) {
            const bf16x8 a = *(const bf16x8*)(VNt + (16 * mt + fr) * 72 + 32 * ks + 8 * g);
            accS[i] = mfma16(a, o.bk[i][ks], accS[i]);
        }
        if (reload) {
#pragma unroll
            for (int ks = 0; ks < C / 32; ++ks) o.bk[i][ks] = *(const bf16x8*)(F.KTT() + (size_t)cnext * 8192 + d * C + 32 * ks + 8 * g);
        }
#pragma unroll
        for (int jj = 0; jj < 4; ++jj) St[(16 * mt + 4 * g + jj) * 136 + d] = (bf16_t)f2bf(accS[i][jj]);
    }
    if (reload) o.gt = F.GT()[cnext * 32];
    __syncthreads();
}
template <int C> __device__ __forceinline__ void gdn_scan(Ctx& F, int chunk0, int nsteps, int m0, int h, int sl, const float* S0, float* Sout) {
    bf16_t* St = (bf16_t*)(F.lds + SL_ST); bf16_t* VNt = (bf16_t*)(F.lds + SL_VN);
    const int lane = F.lane(), wave = F.wave(), fr = lane & 15, g = lane >> 4;
    const int mt = wave & 1, ct = wave >> 1, nt0 = (wave >> 1) * 2;
    const bool act = ct < C / 16;
    const int c = 16 * ct + fr;
    ScanOps<C> A, B;
    scan_load<C>(F, A, chunk0, act, c, sl, mt, nt0, fr, g);
    if (nsteps > 1) scan_load<C>(F, B, chunk0 + 1, act, c, sl, mt, nt0, fr, g);
    f32x4 accS[2];
#pragma unroll
    for (int i = 0; i < 2; ++i) {
        const int d = 16 * (nt0 + i) + fr;
        accS[i] = S0 ? *(const f32x4*)(S0 + (size_t)d * 128 + 32 * sl + 16 * mt + 4 * g) : (f32x4){0.f, 0.f, 0.f, 0.f};
    }
    __syncthreads();
#pragma unroll
    for (int i = 0; i < 2; ++i)
#pragma unroll
        for (int jj = 0; jj < 4; ++jj) St[(16 * mt + 4 * g + jj) * 136 + 16 * (nt0 + i) + fr] = (bf16_t)f2bf(accS[i][jj]);
    __syncthreads();
    for (int s = 0; s < nsteps; s += 2) {
        scan_step<C>(F, A, s + 2 < nsteps, chunk0 + s + 2, accS, St, VNt, act, c, m0 + s * C + c, h, sl, mt, nt0, fr, g);
        if (s + 1 >= nsteps) break;
        scan_step<C>(F, B, s + 3 < nsteps, chunk0 + s + 3, accS, St, VNt, act, c, m0 + (s + 1) * C + c, h, sl, mt, nt0, fr, g);
    }
#pragma unroll
    for (int i = 0; i < 2; ++i) { const int d = 16 * (nt0 + i) + fr; *(f32x4*)(Sout + (size_t)d * 128 + 32 * sl + 16 * mt + 4 * g) = accS[i]; }
}

struct SbState { bf16x8 qf[4]; f32x4 oacc[8]; float R; };
constexpr int AL_K = 0, AL_V = 17408;
template <bool F32SRC> __device__ __forceinline__ void sb_tiles(Ctx& F, SbState& st, bool act, int qpos, int mask_from, int t_lo, int t_hi, int seq_len,
                                                               const bf16_t* kb, const bf16_t* vt, const float* kf, const float* vf) {
    bf16_t* Ks = (bf16_t*)(F.lds + AL_K); bf16_t* Vts = (bf16_t*)(F.lds + AL_V);
    const int lane = F.lane(), tid = F.tid(), fr = lane & 15, g = lane >> 4;
    constexpr int NR = F32SRC ? 4 : 2;
    u32x4 kreg[NR], vreg[NR];
#define SB_LOAD(t) do { _Pragma("unroll") for (int it_ = 0; it_ < 2; ++it_) { const int idx_ = tid + 512 * it_; \
        if (F32SRC) { const int row_ = idx_ >> 4, cc_ = idx_ & 15; const float* s_ = kf + (size_t)((t) * 64 + row_) * 1024 + cc_ * 8; \
            kreg[2 * it_] = *(const u32x4*)s_; kreg[2 * it_ + 1] = *(const u32x4*)(s_ + 4); \
            const int key_ = idx_ & 63, c2_ = idx_ >> 6; const float* v_ = vf + (size_t)((t) * 64 + key_) * 1024 + c2_ * 8; \
            vreg[2 * it_] = *(const u32x4*)v_; vreg[2 * it_ + 1] = *(const u32x4*)(v_ + 4); } \
        else { const int row_ = idx_ >> 4, cc_ = idx_ & 15; const int key_ = (t) * 64 + row_; \
            kreg[it_] = (key_ < seq_len) ? *(const u32x4*)(kb + (size_t)key_ * NP + cc_ * 8) : (u32x4){0u, 0u, 0u, 0u}; \
            const int d_ = idx_ >> 3, c8_ = idx_ & 7; const int tok_ = (t) * 64 + c8_ * 8; \
            vreg[it_] = (tok_ < seq_len) ? *(const u32x4*)(vt + (size_t)d_ * MT + tok_) : (u32x4){0u, 0u, 0u, 0u}; } } } while (0)
#define SB_STORE() do { _Pragma("unroll") for (int it_ = 0; it_ < 2; ++it_) { const int idx_ = tid + 512 * it_; \
        if (F32SRC) { const int row_ = idx_ >> 4, cc_ = idx_ & 15; const u32x4 a_ = kreg[2 * it_], b_ = kreg[2 * it_ + 1]; u32x4 o_; \
            o_.x = pk2(asf(a_.x), asf(a_.y)); o_.y = pk2(asf(a_.z), asf(a_.w)); \
            o_.z = pk2(asf(b_.x), asf(b_.y)); o_.w = pk2(asf(b_.z), asf(b_.w)); \
            *(u32x4*)(Ks + row_ * 136 + cc_ * 8) = o_; \
            const int key_ = idx_ & 63, c2_ = idx_ >> 6; const u32x4 c_ = vreg[2 * it_], d2_ = vreg[2 * it_ + 1]; \
            Vts[(c2_ * 8 + 0) * 72 + key_] = (bf16_t)f2bf(asf(c_.x)); Vts[(c2_ * 8 + 1) * 72 + key_] = (bf16_t)f2bf(asf(c_.y)); \
            Vts[(c2_ * 8 + 2) * 72 + key_] = (bf16_t)f2bf(asf(c_.z)); Vts[(c2_ * 8 + 3) * 72 + key_] = (bf16_t)f2bf(asf(c_.w)); \
            Vts[(c2_ * 8 + 4) * 72 + key_] = (bf16_t)f2bf(asf(d2_.x)); Vts[(c2_ * 8 + 5) * 72 + key_] = (bf16_t)f2bf(asf(d2_.y)); \
            Vts[(c2_ * 8 + 6) * 72 + key_] = (bf16_t)f2bf(asf(d2_.z)); Vts[(c2_ * 8 + 7) * 72 + key_] = (bf16_t)f2bf(asf(d2_.w)); } \
        else { const int row_ = idx_ >> 4, cc_ = idx_ & 15; *(u32x4*)(Ks + row_ * 136 + cc_ * 8) = kreg[it_]; \
            const int d_ = idx_ >> 3, c8_ = idx_ & 7; *(u32x4*)(Vts + d_ * 72 + c8_ * 8) = vreg[it_]; } } } while (0)
    if (!__syncthreads_or(act && st.R != 0.f)) return;
    SB_LOAD(t_hi - 1);
    for (int t = t_hi - 1; t >= t_lo; --t) {
        if (t != t_hi - 1 && !__syncthreads_or(act && st.R != 0.f)) break;
        SB_STORE();
        __syncthreads();
        if (t > t_lo) SB_LOAD(t - 1);
        if (act) {
            f32x4 sc[4];
#pragma unroll
            for (int mt = 0; mt < 4; ++mt) {
                sc[mt] = (f32x4){0.f, 0.f, 0.f, 0.f};
#pragma unroll
                for (int ks = 0; ks < 4; ++ks) sc[mt] = mfma16(*(const bf16x8*)(Ks + (16 * mt + fr) * 136 + 32 * ks + 8 * g), st.qf[ks], sc[mt]);
            }
            const bool masked = t >= mask_from;
            float wt[4][4], T[4], PH[4];
            const float cexp = QSCALE * 1.4426950408889634f;
#pragma unroll
            for (int mt = 0; mt < 4; ++mt) {
                float om[4];
#pragma unroll
                for (int jj = 0; jj < 4; ++jj) {
                    const float x = fminf(sc[mt][jj] * cexp, 100.f);
                    const float e = __builtin_amdgcn_exp2f(x);
                    const float r = __builtin_amdgcn_rcpf(1.f + e);
                    float bt = e * r, o1 = r;
                    if (masked) { const bool valid = (t * 64 + 16 * mt + 4 * g + jj) < qpos; bt = valid ? bt : 0.f; o1 = valid ? o1 : 1.f; }
                    wt[mt][jj] = bt; om[jj] = o1;
                }
                const float e2 = om[3], e1 = om[3] * om[2], e0 = e1 * om[1], G = e0 * om[0];
                wt[mt][3] *= 1.f; wt[mt][2] *= e2; wt[mt][1] *= e1; wt[mt][0] *= e0;
                const float y1 = __shfl_xor(G, 16), y2 = __shfl_xor(G, 32), y3 = __shfl_xor(G, 48);
                T[mt] = G * y1 * y2 * y3;
                PH[mt] = (((g ^ 1) > g) ? y1 : 1.f) * (((g ^ 2) > g) ? y2 : 1.f) * (((g ^ 3) > g) ? y3 : 1.f);
            }
            float suf = st.R;
#pragma unroll
            for (int mt = 3; mt >= 0; --mt) {
                const float f = suf * PH[mt];
#pragma unroll
                for (int jj = 0; jj < 4; ++jj) wt[mt][jj] *= f;
                suf *= T[mt];
            }
            st.R = suf;
            bf16x8 pf[2];
#pragma unroll
            for (int s = 0; s < 2; ++s) {
                u32x4 p; p.x = pk2(wt[2 * s][0], wt[2 * s][1]); p.y = pk2(wt[2 * s][2], wt[2 * s][3]); p.z = pk2(wt[2 * s + 1][0], wt[2 * s + 1][1]); p.w = pk2(wt[2 * s + 1][2], wt[2 * s + 1][3]);
                pf[s] = __builtin_bit_cast(bf16x8, p);
            }
#pragma unroll
            for (int dt = 0; dt < 8; ++dt)
#pragma unroll
                for (int s = 0; s < 2; ++s) {
                    const bf16_t* vp = Vts + (16 * dt + fr) * 72 + 32 * s + 4 * g;
                    const u32x2 lo = *(const u32x2*)vp, hi = *(const u32x2*)(vp + 16);
                    const u32x4 a = {lo.x, lo.y, hi.x, hi.y};
                    st.oacc[dt] = mfma16(__builtin_bit_cast(bf16x8, a), pf[s], st.oacc[dt]);
                }
        }
    }
#undef SB_LOAD
#undef SB_STORE
}
__device__ __forceinline__ void sb_init(Ctx& F, SbState& st, bool act, const bf16_t* q) {
    const int lane = F.lane(), wave = F.wave(), fr = lane & 15, g = lane >> 4;
#pragma unroll
    for (int ks = 0; ks < 4; ++ks) st.qf[ks] = act ? *(const bf16x8*)(q + (size_t)(16 * wave + fr) * NP + 32 * ks + 8 * g) : (bf16x8){0, 0, 0, 0, 0, 0, 0, 0};
#pragma unroll
    for (int dt = 0; dt < 8; ++dt) st.oacc[dt] = (f32x4){0.f, 0.f, 0.f, 0.f};
    st.R = 1.f;
}
__device__ __forceinline__ void sb_store(Ctx& F, const SbState& st, bool act, bf16_t* o_bf) {
    const int lane = F.lane(), wave = F.wave(), fr = lane & 15, g = lane >> 4;
    if (act) {
        const int qi = 16 * wave + fr;
#pragma unroll
        for (int dt = 0; dt < 8; ++dt) { u32x2 o; o.x = pk2(st.oacc[dt][0], st.oacc[dt][1]); o.y = pk2(st.oacc[dt][2], st.oacc[dt][3]); *(u32x2*)(o_bf + (size_t)qi * DM + 16 * dt + 4 * g) = o; }
    }
}

constexpr int Q3_SCANP = 128, Q3_SBP = Q3_SCANP + 512, Q3_SBS = Q3_SBP + 128, Q3_SCANS = Q3_SBS + 512;
constexpr int LT_P1 = 72 * 8 * 6;
__device__ __forceinline__ void p3_mix(Ctx& F) {
    volatile int* slot = (volatile int*)(F.lds + LDS_BYTES - 64);
    unsigned* ctr = F.ctl() + 64;
    const bool shared = (F.G_() == 256);
    const int lt0 = shared ? LT_P1 : 0, lt1 = shared ? I_OUT + I_UP : NT_LATE, q3_end = Q3_SCANS + (lt1 - lt0) / 8;
    for (;;) {
        __syncthreads();
        if (F.tid() == 0) *slot = (int)atomicAdd(ctr, 1u);
        __syncthreads();
        const int it = *slot;
        if (it >= q3_end) break;
        if (it < Q3_SCANP) {
            const int b = it >> 5, h = (it >> 2) & 7, sl = it & 3;
            gdn_scan<64>(F, (b * 8 + h) * 32, 32, b * SEQ, h, sl, nullptr, F.out() + OUT_SP + (size_t)(b * 8 + h) * 16384);
        } else if (it < Q3_SBP) {
            const int idx = it - Q3_SCANP, qb = 15 - (idx >> 5), bh = idx & 31, b = bh >> 3, h = bh & 7;
            const int qrow = b * SEQ + 128 * qb; const int wave = F.wave(), fr = F.lane() & 15;
            SbState st; sb_init(F, st, true, F.PROJ() + (size_t)qrow * NP + 4096 + h * 128);
            sb_tiles<false>(F, st, true, 128 * qb + 16 * wave + fr, 2 * qb, 0, 2 * qb + 2, SEQ,
                            F.PROJ() + (size_t)(b * SEQ) * NP + 5120 + h * 128, F.VT() + (size_t)(h * 128) * MT + b * SEQ, nullptr, nullptr);
            sb_store(F, st, true, F.MIX() + (size_t)qrow * DM + 1024 + h * 128);
        } else if (it < Q3_SBS) {
            const int bh = it - Q3_SBP, b = bh >> 3, h = bh & 7;
            const int qrow = MP + b * DSEQ; const int wave = F.wave(), fr = F.lane() & 15; const bool act = wave < 2;
            SbState st; sb_init(F, st, act, F.PROJ() + (size_t)qrow * NP + 4096 + h * 128);
            sb_tiles<false>(F, st, act, 16 * wave + fr, 0, 0, 1, DSEQ,
                            F.PROJ() + (size_t)qrow * NP + 5120 + h * 128, F.VT() + (size_t)(h * 128) * MT + qrow, nullptr, nullptr);
            sb_tiles<true>(F, st, act, 0, 1 << 30, 0, PAST / 64, PAST, nullptr, nullptr,
                           F.ck() + ((size_t)b * PAST * NH + h) * HD, F.cv() + ((size_t)b * PAST * NH + h) * HD);
            sb_store(F, st, act, F.MIX() + (size_t)qrow * DM + 1024 + h * 128);
        } else if (it < Q3_SCANS) {
            const int idx = it - Q3_SBS, bh = idx >> 2, sl = idx & 3, b = bh >> 3, h = bh & 7;
            gdn_scan<32>(F, NCH_P + bh, 1, MP + b * DSEQ, h, sl, F.st_S() + (size_t)bh * 16384, F.out() + OUT_SS + (size_t)bh * 16384);
        } else {
            p0_transpose_any(F, NT_EARLY + lt0 + (it - Q3_SCANS) * 8 + F.wave(), (float*)(F.lds + F.wave() * 16640));
        }
    }
}

__device__ __forceinline__ void p4_finalize(Ctx& F) {
    const int gw = blockIdx.x * 8 + F.wave(), NGW = F.G_() * 8, lane = F.lane();
    const float nw0 = F.gnorm_w()[2 * lane], nw1 = F.gnorm_w()[2 * lane + 1];
    for (int m = gw; m < MT; m += NGW) {
        float2 o[8]; unsigned zp[8];
#pragma unroll
        for (int h = 0; h < 8; ++h) { o[h] = *(const float2*)(F.OA() + (size_t)m * 1024 + h * 128 + 2 * lane); zp[h] = *(const unsigned*)(F.PROJ() + (size_t)m * NP + 3072 + h * 128 + 2 * lane); }
#pragma unroll
        for (int h = 0; h < 8; ++h) {
            const float rs = rsqrtf(wave_sum(o[h].x * o[h].x + o[h].y * o[h].y) * (1.f / 128.f) + RMS_EPS);
            *(unsigned*)(F.MIX() + (size_t)m * DM + h * 128 + 2 * lane) = pk2(o[h].x * rs * nw0 * silu_f(bflo(zp[h])), o[h].y * rs * nw1 * silu_f(bfhi(zp[h])));
        }
    }
}

template <int NSPLIT, bool RB> __device__ __forceinline__ void ln_load_row(f32x4 (&v)[8], int m, int lane, const float* Y, const float* part, const void* res_s) {
    if (m < MP) {
        const f32x4* yr = (const f32x4*)(Y + (size_t)m * DM);
#pragma unroll
        for (int j = 0; j < 8; ++j) v[j] = __builtin_nontemporal_load(yr + 64 * j + lane);
    } else {
#pragma unroll
        for (int j = 0; j < 8; ++j) {
            u32x2 p[NSPLIT];
#pragma unroll
            for (int sp = 0; sp < NSPLIT; ++sp) p[sp] = ((const u32x2*)((const bf16_t*)part + ((size_t)sp * 512 + (m - MP)) * DM))[64 * j + lane];
            f32x4 a;
            if (RB) { const u32x2 w = ((const u32x2*)((const bf16_t*)res_s + (size_t)(m - MP) * DM))[64 * j + lane]; const unsigned wx = w.x, wy = w.y; a[0] = bflo(wx); a[1] = bfhi(wx); a[2] = bflo(wy); a[3] = bfhi(wy); }
            else a = ((const f32x4*)((const float*)res_s + (size_t)(m - MP) * DM))[64 * j + lane];
            a = a * ALPHA;
#pragma unroll
            for (int sp = 0; sp < NSPLIT; ++sp) { const unsigned px = p[sp].x, py = p[sp].y; a[0] += bflo(px); a[1] += bfhi(px); a[2] += bflo(py); a[3] += bfhi(py); }
            v[j] = a;
        }
    }
}
__device__ __forceinline__ int ln_row_of(int gw, int NGW, int i) {
    if (NGW == 2048) {
        if (gw < 512) return i == 0 ? MP + gw : (i == 1 ? 7680 + gw : -1);
        return i < 5 ? (gw - 512) + 1536 * i : -1;
    }
    const int m = gw + i * NGW; return m < MT ? m : -1;
}
template <int NSPLIT, bool RB> __device__ __forceinline__ void ln_rows(Ctx& F, const float* Y, const float* gam, const float* bet, float* o32, bf16_t* o16, const float* part, const void* res_s) {
    const int gw = blockIdx.x * 8 + F.wave(), NGW = F.G_() * 8, lane = F.lane();
    f32x4 nv[8];
    int m = ln_row_of(gw, NGW, 0);
    if (m >= 0) ln_load_row<NSPLIT, RB>(nv, m, lane, Y, part, res_s);
    for (int i = 0; m >= 0; ++i) {
        f32x4 v[8]; float s = 0.f;
#pragma unroll
        for (int j = 0; j < 8; ++j) { v[j] = nv[j]; s += (v[j][0] + v[j][1]) + (v[j][2] + v[j][3]); }
        const int mn = ln_row_of(gw, NGW, i + 1);
        if (mn >= 0) ln_load_row<NSPLIT, RB>(nv, mn, lane, Y, part, res_s);
        const float mean = wave_sum(s) * (1.f / DM); float s2 = 0.f;
#pragma unroll
        for (int j = 0; j < 8; ++j) { v[j] = v[j] - mean; s2 += (v[j][0] * v[j][0] + v[j][1] * v[j][1]) + (v[j][2] * v[j][2] + v[j][3] * v[j][3]); }
        const float rstd = rsqrtf(wave_sum(s2) * (1.f / DM) + LN_EPS);
#pragma unroll
        for (int j = 0; j < 8; ++j) {
            const f32x4 gg = ((const f32x4*)gam)[64 * j + lane], bb = ((const f32x4*)bet)[64 * j + lane];
            const f32x4 o = v[j] * rstd * gg + bb;
            if (o32) __builtin_nontemporal_store(o, (f32x4*)(o32 + (size_t)m * DM) + 64 * j + lane);
            if (o16) { u32x2 w; w.x = pk2(o[0], o[1]); w.y = pk2(o[2], o[3]); __builtin_nontemporal_store(w, (u32x2*)(o16 + (size_t)m * DM + 256 * j + 4 * lane)); }
        }
        m = mn;
    }
}

#define XB_TMO      128
#define XB_XCNT(j)  (256  + 64 * (j))
#define XB_XSUB(j)  (1280 + 64 * (j))
#define XB_XGEN(j)  (2304 + 64 * (j))
#define XB_TOP      3328
#define XB_TOPGEN   3392
#define XCD_BAR_WORDS 3456
#define XB_SPIN_CAP (1u << 18)

__device__ __forceinline__ unsigned xb_ld(unsigned* p)              { return __hip_atomic_load(p, __ATOMIC_RELAXED, __HIP_MEMORY_SCOPE_AGENT); }
__device__ __forceinline__ unsigned xb_add(unsigned* p, unsigned v) { return __hip_atomic_fetch_add(p, v, __ATOMIC_RELAXED, __HIP_MEMORY_SCOPE_AGENT); }
__device__ __forceinline__ unsigned xb_xcc_id() { return (unsigned)__builtin_amdgcn_s_getreg((3 << 11) | 20) & 0xFu; }
#define XB_SPIN(cond, bar) do { unsigned _sp = 0; while (cond) { __builtin_amdgcn_s_sleep(1); \
    if ((++_sp & 255u) == 0u) { if (xb_ld(&(bar)[XB_TMO])) break; if (_sp > XB_SPIN_CAP) { atomicAdd(&(bar)[XB_TMO], 1u); break; } } } } while (0)

struct XcdBarrier {
    unsigned* bar; unsigned x;
    volatile LAS unsigned* st;
};

__device__ __forceinline__ XcdBarrier xcd_barrier_post(unsigned* bar, volatile LAS unsigned* st) {
    XcdBarrier b; b.bar = bar; b.x = xb_xcc_id(); b.st = st;
    if (threadIdx.x == 0) (void)xb_add(&bar[XB_XCNT(b.x)], 1u);
    return b;
}
__device__ __forceinline__ void xcd_barrier_complete(unsigned* bar, unsigned x, unsigned& nloc, unsigned& nx) {
    const unsigned G = gridDim.x * gridDim.y * gridDim.z;
    unsigned sum, cnt, mine, sp = 0u;
    for (;;) {
        sum = 0u; cnt = 0u; mine = 0u;
#pragma unroll
        for (unsigned j = 0; j < 16; ++j) { const unsigned c = xb_ld(&bar[XB_XCNT(j)]); sum += c; cnt += (c > 0u) ? 1u : 0u; mine = (j == x) ? c : mine; }
        if (sum == G) break;
        __builtin_amdgcn_s_sleep(1);
        if ((++sp & 255u) == 0u) { if (xb_ld(&bar[XB_TMO])) break; if (sp > XB_SPIN_CAP) { atomicAdd(&bar[XB_TMO], 1u); break; } }
    }
    nloc = mine > 0u ? mine : 1u; nx = cnt > 0u ? cnt : 1u;
}

__device__ __forceinline__ void xcd_barrier(const XcdBarrier& b) {
    asm volatile("s_waitcnt vmcnt(0)" ::: "memory");
    __syncthreads();
    if (threadIdx.x == 0) {
        unsigned* bar = b.bar;
        __builtin_amdgcn_s_waitcnt(0);
        unsigned nloc = b.st[0], nx = b.st[1];
        if (nloc == 0u) { xcd_barrier_complete(bar, b.x, nloc, nx); b.st[0] = nloc; b.st[1] = nx; }
        const unsigned old = xb_add(&bar[XB_XSUB(b.x)], 1u);
        const unsigned gen = old / nloc;
        if (old + 1u == (gen + 1u) * nloc) {
            __builtin_amdgcn_fence(__ATOMIC_RELEASE, "agent");
            asm volatile("s_waitcnt vmcnt(0)" ::: "memory");
            const unsigned og = xb_add(&bar[XB_TOP], 1u);
            const unsigned tg = og / nx;
            if (og + 1u == (tg + 1u) * nx) xb_add(&bar[XB_TOPGEN], 1u);
            else XB_SPIN(xb_ld(&bar[XB_TOPGEN]) == tg, bar);
            __builtin_amdgcn_fence(__ATOMIC_ACQUIRE, "agent");
            xb_add(&bar[XB_XGEN(b.x)], 1u);
            asm volatile("s_waitcnt vmcnt(0)" ::: "memory");
        } else {
            XB_SPIN(xb_ld(&bar[XB_XGEN(b.x)]) == gen, bar);
            __builtin_amdgcn_fence(__ATOMIC_ACQUIRE, "agent");
            asm volatile("s_waitcnt vmcnt(0)" ::: "memory");
        }
    }
    __syncthreads();
}

struct Args { const float* in[18]; float* out; unsigned char* ws; int ph_lo, ph_hi; };
__global__ void __launch_bounds__(512, 2) mk_fwd(Args args) {
    extern __shared__ __attribute__((aligned(16))) unsigned char lds[];
    cg::grid_group grid = cg::this_grid();
    Ctx F;
    F.kp = (kptr_t)__builtin_amdgcn_kernarg_segment_ptr();
    F.lds = lds;
    const int lo = args.ph_lo, hi = args.ph_hi;
    volatile LAS unsigned* misc = (volatile LAS unsigned*)(lds + LDS_BYTES - 128);
    if (threadIdx.x < 2) misc[threadIdx.x] = 0u;
    __syncthreads();
    XcdBarrier bar = xcd_barrier_post(F.ctl() + 4096, misc);
#define IN(k) (lo <= (k) && (k) < hi)
#define SEAM(k) do { if (IN(k) && IN((k) + 1)) { xcd_barrier(bar); } } while (0)
    LAS unsigned char* ldsl = (LAS unsigned char*)lds;

    if (lo > hi) grid.sync();
    if (IN(0)) p0_prologue(F);
    SEAM(0);
    if (IN(1)) {
        pg8::Gemm g{F.XB(), F.WinT(), MT, NP, DM}; pg8::StaticOrder S; S.init(MT, NP, F.G_(), (int)blockIdx.x, DM);
        pg8::EpiProj E{F.PROJ(), F.out(), OUT_CONVP, OUT_KP, OUT_VP, OUT_CONVS, OUT_KS, OUT_VS};
        pg8::gemm_phase<pg8::EpiProj, pg8::StaticOrder, true, true>(ldsl, g, S, E);
        if (F.G_() == 256 && blockIdx.x >= 184) {
            for (int j = 0; j < 6; ++j) p0_transpose_any(F, NT_EARLY + ((int)blockIdx.x - 184) * 48 + j * 8 + F.wave(), (float*)(F.lds + F.wave() * 16640));
        }
    }
    SEAM(1);
    if (IN(2)) p2_prep(F);
    SEAM(2);
    if (IN(3)) p3_mix(F);
    SEAM(3);
    if (IN(4)) p4_finalize(F);
    SEAM(4);
    if (IN(5)) {
        pg8::Gemm g{F.MIX(), F.WoutT(), MT, DM, DM}; pg8::SplitOrder S; S.init(MP, MT, DM, DM, NSPLIT1, F.G_(), (int)blockIdx.x);
        pg8::EpiRes<true> E{F.XB(), F.XB(), MT, F.Y1(), DM, ALPHA, F.PART1()};
        pg8::gemm_phase<pg8::EpiRes<true>, pg8::SplitOrder, true, true>(ldsl, g, S, E);
    }
    SEAM(5);
    if (IN(6)) ln_rows<NSPLIT1, false>(F, F.Y1(), F.ln1_g(), F.ln1_b(), nullptr, F.XB(), F.PART1(), F.x_sample());
    SEAM(6);
    if (IN(7)) {
        pg8::Gemm g{F.XB(), F.WupT(), MT, FF, DM}; pg8::StaticOrder S; S.init(MT, FF, F.G_(), (int)blockIdx.x, DM);
        pg8::EpiUp E{F.HB(), FF};
        pg8::gemm_phase<pg8::EpiUp, pg8::StaticOrder, true, true>(ldsl, g, S, E);
        if (F.G_() == 256 && blockIdx.x >= 64) {
            for (int idx = ((int)blockIdx.x - 64) * 8 + F.wave(); idx < I_DN; idx += 192 * 8) p0_transpose_any(F, NT_EARLY + I_OUT + I_UP + idx, (float*)(F.lds + F.wave() * 16640));
        }
    }
    SEAM(7);
    if (IN(8)) {
        pg8::Gemm g{F.HB(), F.WdnT(), MT, DM, FF}; pg8::SplitOrder S; S.init(MP, MT, DM, FF, NSPLIT2, F.G_(), (int)blockIdx.x);
        pg8::EpiRes<true> E{F.XB(), F.XB(), MT, F.Y2(), DM, ALPHA, F.PART2()};
        pg8::gemm_phase<pg8::EpiRes<true>, pg8::SplitOrder, true, true>(ldsl, g, S, E);
    }
    SEAM(8);
    if (IN(9)) ln_rows<NSPLIT2, true>(F, F.Y2(), F.ln2_g(), F.ln2_b(), F.out() + OUT_YP, nullptr, F.PART2(), F.XB() + (size_t)MP * DM);
#undef IN
#undef SEAM
}

extern "C" void kernel_launch(void* const* d_in, const int* in_sizes, int n_in, void* d_out, int out_size, void* d_ws, size_t ws_size, hipStream_t stream) {
    static int grid = 0;
    if (grid == 0) {
        if (n_in != 18 || (size_t)out_size != OUT_END || ws_size < WS_END) { fprintf(stderr, "kernel_launch: unexpected shapes: n_in %d out %d ws %zu (need %zu)\n", n_in, out_size, ws_size, (size_t)WS_END); grid = -1; return; }
        int dev = 0, cus = 0, per_cu = 0;
        hipGetDevice(&dev); hipDeviceGetAttribute(&cus, hipDeviceAttributeMultiprocessorCount, dev);
        if (hipFuncSetAttribute((const void*)mk_fwd, hipFuncAttributeMaxDynamicSharedMemorySize, LDS_BYTES) != hipSuccess) { fprintf(stderr, "kernel_launch: hipFuncSetAttribute failed\n"); grid = -1; return; }
        if (hipOccupancyMaxActiveBlocksPerMultiprocessor(&per_cu, (const void*)mk_fwd, 512, LDS_BYTES) != hipSuccess || per_cu < 1) { fprintf(stderr, "kernel_launch: occupancy query says %d\n", per_cu); per_cu = 1; }
        (void)hipGetLastError();
        grid = cus * (per_cu > 1 ? 1 : per_cu);
        if (grid <= 0) grid = 256;
    }
    if (grid < 0) return;
    hipMemsetAsync((char*)d_ws + WS_CTL, 0, 65536, stream);
    Args a{};
    for (int i = 0; i < 18; ++i) a.in[i] = (const float*)d_in[i];
    a.out = (float*)d_out; a.ws = (unsigned char*)d_ws;
    void* kargs[] = {&a};
#if MK_N_LAUNCHES == 1
    a.ph_lo = 0; a.ph_hi = NPHASE;
    hipError_t e = hipLaunchCooperativeKernel((const void*)mk_fwd, dim3(grid), dim3(512), kargs, LDS_BYTES, stream);
    if (e != hipSuccess) fprintf(stderr, "cooperative launch failed: %s (grid %d)\n", hipGetErrorString(e), grid);
#else
    for (int p = 0; p < NPHASE; ++p) {
        a.ph_lo = p; a.ph_hi = p + 1;
        hipError_t e = hipLaunchCooperativeKernel((const void*)mk_fwd, dim3(grid), dim3(512), kargs, LDS_BYTES, stream);
        if (e != hipSuccess) { fprintf(stderr, "cooperative launch %d failed: %s (grid %d)\n", p, hipGetErrorString(e), grid); break; }
    }
#endif
}
```

```cpp
#include <hip/hip_runtime.h>
#include <hip/hip_cooperative_groups.h>
#include <cstdio>
#include <cstdint>
namespace cg = cooperative_groups;

#ifndef MK_N_LAUNCHES
#define MK_N_LAUNCHES 1
#endif

namespace pg8 {
#define PG8_LAS __attribute__((address_space(3)))
typedef unsigned short bf16_t;
typedef short bf16x8 __attribute__((ext_vector_type(8)));
typedef float f32x4 __attribute__((ext_vector_type(4)));
typedef unsigned u32x4 __attribute__((ext_vector_type(4)));
constexpr int BM = 256, BK = 64, HALF = 128, HTB = HALF * BK * 2  , STAGE_BYTES = 8 * HTB, NXCD = 8, WGM = 8;

__host__ __device__ __forceinline__ int lds_byte(int r, int c) { const int st = (r >> 4) * 2 + (c >> 5), rr = r & 15, cc = c & 31, ob = rr * 64 + cc * 2; return st * 1024 + (ob ^ (((ob >> 9) & 1) << 5)); }
__host__ __device__ __forceinline__ void stage_rc(int b, int& R, int& C) { const int st = b / 1024, sb = b % 1024, swz = sb ^ (((sb >> 9) & 1) << 5); R = (st >> 1) * 16 + swz / 64; C = (st & 1) * 32 + (swz % 64) / 2; }
__host__ __device__ __forceinline__ int perm32(int rho) { const int n = rho >> 4, i = rho & 15; return 8 * (i >> 2) + 4 * n + (i & 3); }

struct Unit { int pm, pn, k0, nt, split; };
struct Gemm { const bf16_t* A; const bf16_t* Bt; int M, N, K; };

struct StaticOrder {
    int nM, nN, nwg, G, c, ntk;
    __host__ __device__ void init(int M, int N, int G_, int c_, int K) { nM = M / BM; nN = N / BM; nwg = nM * nN; G = G_; c = c_; ntk = K / BK; }
    __host__ __device__ bool next(int i, Unit& u) const {
        const long L = (long)i * G + c; if (L >= nwg) return false;
        int wgid = (int)L; { const int q = nwg / NXCD, r = nwg % NXCD, xcd = wgid % NXCD, off = wgid / NXCD; wgid = (xcd < r ? xcd * (q + 1) : r * (q + 1) + (xcd - r) * q) + off; }
        const int nig = WGM * nN, gid = wgid / nig, fm = gid * WGM, gsz = (nM - fm) < WGM ? (nM - fm) : WGM;
        u.pm = fm + ((wgid % nig) % gsz); u.pn = (wgid % nig) / gsz; u.k0 = 0; u.nt = ntk; u.split = -1; return true;
    }
    __device__ __forceinline__ void a_ready(const Unit&) const {}
    __device__ __forceinline__ void done(const Unit&) const {}
};
struct SplitOrder {
    StaticOrder S; int nmain, nN, nMm, nsplit, ntk, G, c, ntail;
    __host__ __device__ void init(int Mmain, int Mtot, int N, int K, int nsplit_, int G_, int c_) {
        S.init(Mmain, N, G_, c_, K); G = G_; c = c_; nN = N / BM; nMm = Mmain / BM; nsplit = nsplit_; ntk = K / BK / nsplit_;
        nmain = (S.nwg > c_) ? (S.nwg - c_ + G_ - 1) / G_ : 0;
        ntail = (Mtot - Mmain) / BM * nN * nsplit_;
    }
    __host__ __device__ bool next(int i, Unit& u) const {
        if (i < nmain) return S.next(i, u);
        const long sub = (long)(i - nmain) * G + c; if (sub >= ntail) return false;
        const int tile = (int)sub / nsplit, ks = (int)sub % nsplit;
        u.pm = nMm + tile / nN; u.pn = tile % nN; u.k0 = ks * ntk; u.nt = ntk; u.split = ks; return true;
    }
    __device__ __forceinline__ void a_ready(const Unit&) const {}
    __device__ __forceinline__ void done(const Unit&) const {}
};

__device__ __forceinline__ unsigned cvt_pk_bf16(float lo, float hi) { unsigned r; asm volatile("v_cvt_pk_bf16_f32 %0, %1, %2" : "=v"(r) : "v"(lo), "v"(hi)); return r; }
typedef float f32x2 __attribute__((ext_vector_type(2)));
typedef unsigned u32x2 __attribute__((ext_vector_type(2)));
struct EpiProj {
    static constexpr bool PERM = true, AFTER_DRAIN = false;
    bf16_t* O; float* outp;
    size_t off_convp, off_kp, off_vp, off_convs, off_ks, off_vs;
    __device__ __forceinline__ void operator()(const f32x4 (&acc)[2][2][4][2], const Unit& u, int wr, int wc, int fr, int fq) const {
        const int row0 = u.pm * BM + wr * 64 + fr; const int colt = u.pn * BM; const int col0 = colt + wc * 32 + 8 * fq;
        const bool is_k = (colt >= 5120 && colt < 6144), is_v = (colt >= 6144), is_conv = (colt < 3072), samp = (u.pm >= 32);
#pragma unroll
        for (int ai = 0; ai < 2; ++ai)
#pragma unroll
            for (int m = 0; m < 4; ++m) {
                const int row = row0 + ai * HALF + m * 16;
                bf16_t* rowp = O + (size_t)row * 7168 + col0;
#pragma unroll
                for (int bj = 0; bj < 2; ++bj) {
                    const f32x4 v0 = acc[ai][bj][m][0], v1 = acc[ai][bj][m][1];
                    u32x4 w; w.x = cvt_pk_bf16(v0[0], v0[1]); w.y = cvt_pk_bf16(v0[2], v0[3]); w.z = cvt_pk_bf16(v1[0], v1[1]); w.w = cvt_pk_bf16(v1[2], v1[3]);
                    *(u32x4*)(rowp + bj * HALF) = w;
                    const int col = col0 + bj * HALF;
                    if (is_k || is_v) {
                        float* dst = outp + (samp ? (is_k ? off_ks : off_vs) + (size_t)(row - 8192) * 1024 : (is_k ? off_kp : off_vp) + (size_t)row * 1024) + (col - (is_k ? 5120 : 6144));
                        *(f32x4*)dst = v0; *(f32x4*)(dst + 4) = v1;
                    }
                    if (is_conv) {
                        if (!samp) { const int t = row & 2047; if (t >= 2045) { float* dst = outp + off_convp + (size_t)((row >> 11) * 3 + (t - 2045)) * 3072 + col; *(f32x4*)dst = v0; *(f32x4*)(dst + 4) = v1; } }
                        else { const int rs = row - 8192, t = rs & 31; if (t >= 29) { float* dst = outp + off_convs + (size_t)((rs >> 5) * 3 + (t - 29)) * 3072 + col; *(f32x4*)dst = v0; *(f32x4*)(dst + 4) = v1; } }
                    }
                }
            }
    }
};
struct EpiUp {
    static constexpr bool PERM = true, AFTER_DRAIN = false;
    bf16_t* O; int ldc;
    __device__ __forceinline__ void operator()(const f32x4 (&acc)[2][2][4][2], const Unit& u, int wr, int wc, int fr, int fq) const {
        const int row0 = u.pm * BM + wr * 64 + fr; const int col0 = u.pn * BM + wc * 32 + 8 * fq;
#pragma unroll
        for (int ai = 0; ai < 2; ++ai)
#pragma unroll
            for (int m = 0; m < 4; ++m) {
                bf16_t* rowp = O + (size_t)(row0 + ai * HALF + m * 16) * ldc + col0;
#pragma unroll
                for (int bj = 0; bj < 2; ++bj) {
                    f32x4 v0 = acc[ai][bj][m][0], v1 = acc[ai][bj][m][1];
#pragma unroll
                    for (int e = 0; e < 4; ++e) { const float a = fmaxf(v0[e], 0.f), b = fmaxf(v1[e], 0.f); v0[e] = a * a; v1[e] = b * b; }
                    u32x4 w; w.x = cvt_pk_bf16(v0[0], v0[1]); w.y = cvt_pk_bf16(v0[2], v0[3]); w.z = cvt_pk_bf16(v1[0], v1[1]); w.w = cvt_pk_bf16(v1[2], v1[3]);
                    *(u32x4*)(rowp + bj * HALF) = w;
                }
            }
    }
};
template <bool RB> struct EpiRes {
    static constexpr bool PERM = false, AFTER_DRAIN = false;
    const void* res0; const void* res1; int split; bf16_t* out; int ldc; float alpha; float* part;
    __device__ __forceinline__ void operator()(const f32x4 (&acc)[2][2][4][2], const Unit& u, int wr, int wc, int fr, int fq) const {
        const int col0 = u.pn * BM + wc * 32 + 4 * fq;
        if (u.split >= 0) {
#pragma unroll
            for (int ai = 0; ai < 2; ++ai)
#pragma unroll
                for (int m = 0; m < 4; ++m) {
                    const int row = u.pm * BM + ai * HALF + wr * 64 + m * 16 + fr;
                    bf16_t* op = (bf16_t*)part + ((size_t)u.split * 512 + (row - 8192)) * ldc + col0;
#pragma unroll
                    for (int bj = 0; bj < 2; ++bj)
#pragma unroll
                        for (int n = 0; n < 2; ++n) { const f32x4 a = acc[ai][bj][m][n]; u32x2 w2; w2.x = cvt_pk_bf16(a[0], a[1]); w2.y = cvt_pk_bf16(a[2], a[3]); *(u32x2*)(op + bj * HALF + n * 16) = w2; }
                }
            return;
        }
#pragma unroll
        for (int ai = 0; ai < 2; ++ai) {
            f32x4 r[4][2][2];
#pragma unroll
            for (int m = 0; m < 4; ++m) {
                const int row = u.pm * BM + ai * HALF + wr * 64 + m * 16 + fr;
                const size_t roff = (row < split ? (size_t)row : (size_t)(row - split)) * ldc + col0;
                const void* rb = row < split ? res0 : res1;
#pragma unroll
                for (int bj = 0; bj < 2; ++bj)
#pragma unroll
                    for (int n = 0; n < 2; ++n) {
                        if (RB) { const u32x2 w = *(const u32x2*)((const bf16_t*)rb + roff + bj * HALF + n * 16); const unsigned wx = w.x, wy = w.y;
                                  r[m][bj][n][0] = __builtin_bit_cast(float, wx << 16); r[m][bj][n][1] = __builtin_bit_cast(float, wx & 0xffff0000u); r[m][bj][n][2] = __builtin_bit_cast(float, wy << 16); r[m][bj][n][3] = __builtin_bit_cast(float, wy & 0xffff0000u); }
                        else r[m][bj][n] = *(const f32x4*)((const float*)rb + roff + bj * HALF + n * 16);
                    }
            }
#pragma unroll
            for (int m = 0; m < 4; ++m) {
                const int row = u.pm * BM + ai * HALF + wr * 64 + m * 16 + fr;
                bf16_t* op = out + (size_t)row * ldc + col0;
#pragma unroll
                for (int bj = 0; bj < 2; ++bj)
#pragma unroll
                    for (int n = 0; n < 2; ++n) { const f32x4 o = r[m][bj][n] * alpha + acc[ai][bj][m][n]; u32x2 w2; w2.x = cvt_pk_bf16(o[0], o[1]); w2.y = cvt_pk_bf16(o[2], o[3]); *(u32x2*)(op + bj * HALF + n * 16) = w2; }
            }
        }
    }
};

template <class Epi, class Sched, bool ALIGN_EPI = false, bool SP2 = false>
__device__ __forceinline__ void gemm_phase(PG8_LAS unsigned char* lds, const Gemm g, const Sched& S, const Epi& E) {
    const int tid = threadIdx.x, wid = __builtin_amdgcn_readfirstlane(tid >> 6), lane = tid & 63, wr = wid >> 2, wc = wid & 3, fr = lane & 15, fq = lane >> 4;
    const int K = g.K;
    unsigned voffA[2], voffB[2];
#pragma unroll
    for (int i = 0; i < 2; ++i) { int R, C; stage_rc(tid * 16 + i * 8192, R, C); const int Rb = Epi::PERM ? ((R & ~31) + perm32(R & 31)) : R;
        voffA[i] = (unsigned)(R * K + C) * 2u; voffB[i] = (unsigned)(Rb * K + C) * 2u; }
    const size_t kstep = (size_t)(BK * 2);
    const size_t hstep = (size_t)HALF * K * 2;
    const size_t tstep = 2 * hstep;
    const unsigned ldsw = (unsigned)wid * 1024u;
    const int aoff = lds_byte(wr * 64 + fr, fq * 8), boff = lds_byte(wc * 32 + fr, fq * 8);
#define PG8_SA(b, h) (((b) * 2 + (h)) * HTB)
#define PG8_SB(b, h) ((4 + (b) * 2 + (h)) * HTB)
#define PG8_STAGE(bufoff, gbase, voff) do { _Pragma("unroll") for (int _i = 0; _i < 2; ++_i) \
        __builtin_amdgcn_global_load_lds((const unsigned*)((const char*)(gbase) + (voff)[_i]), (PG8_LAS unsigned*)(lds + (bufoff) + ldsw + _i * 8192), 16, 0, 0); } while (0)
#define PG8_LDA(dst, b, h) do { _Pragma("unroll") for (int m = 0; m < 4; ++m) _Pragma("unroll") for (int k = 0; k < 2; ++k) dst[m][k] = *(const PG8_LAS bf16x8*)(lds + PG8_SA(b, h) + aoff + m * 2048 + k * 1024); } while (0)
#define PG8_LDB(dst, b, h) do { _Pragma("unroll") for (int n = 0; n < 2; ++n) _Pragma("unroll") for (int k = 0; k < 2; ++k) dst[n][k] = *(const PG8_LAS bf16x8*)(lds + PG8_SB(b, h) + boff + n * 2048 + k * 1024); } while (0)
#define PG8_MMA(ai, bj, At, Bt) do { __builtin_amdgcn_s_setprio(1); _Pragma("unroll") for (int m = 0; m < 4; ++m) _Pragma("unroll") for (int n = 0; n < 2; ++n) _Pragma("unroll") for (int k = 0; k < 2; ++k) \
        acc[ai][bj][m][n] = __builtin_amdgcn_mfma_f32_16x16x32_bf16(Bt[n][k], At[m][k], acc[ai][bj][m][n], 0, 0, 0); __builtin_amdgcn_s_setprio(0); } while (0)
#define PG8_WAIT_V(n) asm volatile("s_waitcnt vmcnt(" #n ")" ::: "memory")
#define PG8_WAIT_L(n) asm volatile("s_waitcnt lgkmcnt(" #n ")" ::: "memory")
#define PG8_BAR __builtin_amdgcn_s_barrier()
#define PG8_SCHED __builtin_amdgcn_sched_barrier(0)
    Unit cur, nxt; int ui = 0;
    if (!S.next(0, cur)) return;
    f32x4 acc[2][2][4][2];
#pragma unroll
    for (int a = 0; a < 2; ++a)
#pragma unroll
        for (int b = 0; b < 2; ++b)
#pragma unroll
            for (int m = 0; m < 4; ++m)
#pragma unroll
                for (int n = 0; n < 2; ++n) acc[a][b][m][n] = (f32x4){0.f, 0.f, 0.f, 0.f};
    bf16x8 At[4][2], B0[2][2], B1[2][2];
    const char* cA = (const char*)g.A + (size_t)cur.pm * tstep + (size_t)cur.k0 * kstep; const char* cB = (const char*)g.Bt + (size_t)cur.pn * tstep + (size_t)cur.k0 * kstep;
    S.a_ready(cur);
    if constexpr (SP2) {
        PG8_STAGE(PG8_SB(0, 0), cB, voffB); PG8_STAGE(PG8_SB(0, 1), cB + hstep, voffB); PG8_STAGE(PG8_SA(0, 0), cA, voffA); PG8_STAGE(PG8_SA(0, 1), cA + hstep, voffA);
        if (wr == 1) PG8_BAR;
        PG8_WAIT_V(2); PG8_BAR;
        PG8_STAGE(PG8_SB(1, 0), cB + kstep, voffB); PG8_STAGE(PG8_SA(1, 0), cA + kstep, voffA); PG8_STAGE(PG8_SB(1, 1), cB + hstep + kstep, voffB);
        PG8_WAIT_V(6); PG8_BAR;
    } else {
        PG8_STAGE(PG8_SB(0, 0), cB, voffB); PG8_STAGE(PG8_SA(0, 0), cA, voffA); PG8_STAGE(PG8_SB(0, 1), cB + hstep, voffB); PG8_STAGE(PG8_SA(0, 1), cA + hstep, voffA);
        if (wr == 1) PG8_BAR;
        PG8_WAIT_V(4); PG8_BAR;
        PG8_STAGE(PG8_SB(1, 0), cB + kstep, voffB); PG8_STAGE(PG8_SA(1, 0), cA + kstep, voffA); PG8_STAGE(PG8_SB(1, 1), cB + hstep + kstep, voffB);
        PG8_WAIT_V(6); PG8_BAR;
    }
    for (;;) {
        const bool has_next = S.next(ui + 1, nxt);
        const char* nA = has_next ? (const char*)g.A + (size_t)nxt.pm * tstep + (size_t)nxt.k0 * kstep : cA; const char* nB = has_next ? (const char*)g.Bt + (size_t)nxt.pn * tstep + (size_t)nxt.k0 * kstep : cB;
        const int nt = cur.nt;
        for (int t = 0; t < nt; t += 2) {
            const bool last = (t == nt - 2);
            const char* a1 = cA + (size_t)(t + 1) * kstep;
            const char* a2 = last ? nA : cA + (size_t)(t + 2) * kstep; const char* b2 = last ? nB : cB + (size_t)(t + 2) * kstep;
            const char* a3 = a2 + kstep; const char* b3 = b2 + kstep;
            if (last && has_next) S.a_ready(nxt);
            if constexpr (SP2) {
            PG8_LDB(B0, 0, 0); PG8_LDB(B1, 0, 1); PG8_SCHED; PG8_LDA(At, 0, 0); PG8_STAGE(PG8_SA(1, 1), a1 + hstep, voffA);
            PG8_WAIT_V(8); PG8_WAIT_L(0); PG8_BAR; PG8_MMA(0, 0, At, B0); PG8_MMA(0, 1, At, B1); PG8_BAR; PG8_SCHED;
            PG8_LDA(At, 0, 1); PG8_STAGE(PG8_SB(0, 0), b2, voffB); PG8_STAGE(PG8_SB(0, 1), b2 + hstep, voffB); PG8_STAGE(PG8_SA(0, 0), a2, voffA);
            PG8_WAIT_V(8); PG8_WAIT_L(0); PG8_BAR; PG8_MMA(1, 0, At, B0); PG8_MMA(1, 1, At, B1); PG8_BAR; PG8_SCHED;
            PG8_LDB(B0, 1, 0); PG8_LDB(B1, 1, 1); PG8_SCHED; PG8_LDA(At, 1, 0); PG8_STAGE(PG8_SA(0, 1), a2 + hstep, voffA);
            PG8_WAIT_V(8); PG8_WAIT_L(0); PG8_BAR; PG8_MMA(0, 0, At, B0); PG8_MMA(0, 1, At, B1); PG8_BAR; PG8_SCHED;
            PG8_LDA(At, 1, 1); PG8_STAGE(PG8_SB(1, 0), b3, voffB); PG8_STAGE(PG8_SB(1, 1), b3 + hstep, voffB); PG8_STAGE(PG8_SA(1, 0), a3, voffA);
            PG8_WAIT_V(8); PG8_WAIT_L(0); PG8_BAR; PG8_MMA(1, 0, At, B0); PG8_MMA(1, 1, At, B1); PG8_BAR; PG8_SCHED;
            } else {
            PG8_LDB(B0, 0, 0); PG8_SCHED; PG8_LDA(At, 0, 0); PG8_STAGE(PG8_SA(1, 1), a1 + hstep, voffA);
            PG8_WAIT_L(8); PG8_BAR; PG8_WAIT_L(0); PG8_MMA(0, 0, At, B0); PG8_BAR; PG8_SCHED;
            PG8_LDB(B1, 0, 1); PG8_STAGE(PG8_SB(0, 0), b2, voffB);
            PG8_BAR; PG8_WAIT_L(0); PG8_MMA(0, 1, At, B1); PG8_BAR;
            PG8_LDA(At, 0, 1); PG8_STAGE(PG8_SA(0, 0), a2, voffA);
            PG8_BAR; PG8_WAIT_L(0); PG8_MMA(1, 0, At, B0); PG8_BAR; PG8_SCHED;
            PG8_STAGE(PG8_SB(0, 1), b2 + hstep, voffB);
            PG8_WAIT_V(6); PG8_BAR; PG8_MMA(1, 1, At, B1); PG8_BAR;
            PG8_LDB(B0, 1, 0); PG8_SCHED; PG8_LDA(At, 1, 0); PG8_STAGE(PG8_SA(0, 1), a2 + hstep, voffA);
            PG8_WAIT_L(8); PG8_BAR; PG8_WAIT_L(0); PG8_MMA(0, 0, At, B0); PG8_BAR; PG8_SCHED;
            PG8_LDB(B1, 1, 1); PG8_STAGE(PG8_SB(1, 0), b3, voffB);
            PG8_BAR; PG8_WAIT_L(0); PG8_MMA(0, 1, At, B1); PG8_BAR;
            PG8_LDA(At, 1, 1); PG8_STAGE(PG8_SA(1, 0), a3, voffA);
            PG8_BAR; PG8_WAIT_L(0); PG8_MMA(1, 0, At, B0); PG8_BAR; PG8_SCHED;
            PG8_STAGE(PG8_SB(1, 1), b3 + hstep, voffB);
            PG8_WAIT_V(6); PG8_BAR; PG8_MMA(1, 1, At, B1); PG8_BAR;
            }
        }
        if constexpr (ALIGN_EPI) { if (wr == 0) PG8_BAR; }
        if constexpr (!Epi::AFTER_DRAIN) { E(acc, cur, wr, wc, fr, fq); S.done(cur); }
        if (!has_next) break;
#pragma unroll
        for (int a = 0; a < 2; ++a)
#pragma unroll
            for (int b = 0; b < 2; ++b)
#pragma unroll
                for (int m = 0; m < 4; ++m)
#pragma unroll
                    for (int n = 0; n < 2; ++n) acc[a][b][m][n] = (f32x4){0.f, 0.f, 0.f, 0.f};
        cur = nxt; cA = nA; cB = nB; ++ui;
        if constexpr (ALIGN_EPI) { if (wr == 1) PG8_BAR; }
    }
    PG8_WAIT_V(0);
    if constexpr (!ALIGN_EPI) { if (wr == 0) PG8_BAR; }
    PG8_BAR;
    if constexpr (Epi::AFTER_DRAIN) { E.fused(acc, cur, wr, wc, fr, fq, lds, wid, lane); S.done(cur); }
#undef PG8_SA
#undef PG8_SB
#undef PG8_STAGE
#undef PG8_LDA
#undef PG8_LDB
#undef PG8_MMA
#undef PG8_WAIT_V
#undef PG8_WAIT_L
#undef PG8_BAR
#undef PG8_SCHED
}
}

typedef unsigned short bf16_t;
typedef short bf16x8 __attribute__((ext_vector_type(8)));
typedef short bf16x4 __attribute__((ext_vector_type(4)));
typedef float f32x4 __attribute__((ext_vector_type(4)));
typedef unsigned u32x4 __attribute__((ext_vector_type(4)));
typedef unsigned u32x2 __attribute__((ext_vector_type(2)));
#define LAS __attribute__((address_space(3)))

constexpr int DM = 2048, MP = 8192, MS = 512, MT = 8704, NP = 7168, FF = 8192;
constexpr int NH = 8, HD = 128, SEQ = 2048, DSEQ = 32, PAST = 2048, NB = 4, NDB = 16;
constexpr int NCH_P = 1024, NCH = 1152;
constexpr float ALPHA = 1.189207115002721f;
constexpr float QSCALE = 0.08838834764831845f;
constexpr float LN_EPS = 1e-5f, RMS_EPS = 1e-6f, L2_EPS = 1e-6f;
constexpr int NPHASE = 10;

constexpr size_t OUT_YP = 0, OUT_YS = OUT_YP + (size_t)MP * DM, OUT_CONVP = OUT_YS + (size_t)MS * DM, OUT_SP = OUT_CONVP + (size_t)NB * 3 * 3072,
    OUT_KP = OUT_SP + (size_t)NB * NH * HD * HD, OUT_VP = OUT_KP + (size_t)MP * 1024, OUT_CONVS = OUT_VP + (size_t)MP * 1024, OUT_SS = OUT_CONVS + (size_t)NDB * 3 * 3072,
    OUT_KS = OUT_SS + (size_t)NDB * NH * HD * HD, OUT_VS = OUT_KS + (size_t)MS * 1024, OUT_END = OUT_VS + (size_t)MS * 1024;

constexpr size_t MiB = 1u << 20;
constexpr size_t WS_CTL = 0, CTL_BYTES = 1 * MiB;
constexpr size_t WS_WIN = 1 * MiB, WS_WOUT = 29 * MiB, WS_WUP = 37 * MiB, WS_WDN = 69 * MiB, WS_XB = 101 * MiB, WS_BA = 135 * MiB;
constexpr size_t WS_PROJ = 136 * MiB, WS_VT = 255 * MiB, WS_H = 136 * MiB;
constexpr size_t WS_U = 272 * MiB, WS_NW = 308 * MiB, WS_QD = 326 * MiB, WS_KTT = 344 * MiB, WS_ATT = 362 * MiB, WS_GT = 371 * MiB;
constexpr size_t WS_OA = 372 * MiB, WS_MIX = 406 * MiB, WS_PO = 440 * MiB, WS_PR = 450 * MiB, WS_END = 451 * MiB;
constexpr size_t WS_Y1 = 272 * MiB, WS_X1 = 340 * MiB, WS_Y2 = 272 * MiB;
constexpr size_t WS_PART1 = 136 * MiB, WS_PART2 = 1 * MiB;
constexpr int NSPLIT1 = 8, NSPLIT2 = 16;
constexpr int LDS_BYTES = 147456;

__device__ __forceinline__ unsigned f2bf(float f) { unsigned u = __builtin_bit_cast(unsigned, f); return (u + 0x7fffu + ((u >> 16) & 1u)) >> 16; }
__device__ __forceinline__ unsigned pk2(float lo, float hi) { unsigned r; asm volatile("v_cvt_pk_bf16_f32 %0, %1, %2" : "=v"(r) : "v"(lo), "v"(hi)); return r; }
__device__ __forceinline__ float asf(unsigned u) { return __builtin_bit_cast(float, u); }
__device__ __forceinline__ float bflo(unsigned p) { return __builtin_bit_cast(float, p << 16); }
__device__ __forceinline__ float bfhi(unsigned p) { return __builtin_bit_cast(float, p & 0xffff0000u); }
__device__ __forceinline__ f32x4 mfma16(bf16x8 a, bf16x8 b, f32x4 c) { return __builtin_amdgcn_mfma_f32_16x16x32_bf16(a, b, c, 0, 0, 0); }
__device__ __forceinline__ float wave_sum(float v) {
#pragma unroll
    for (int o = 1; o < 64; o <<= 1) v += __shfl_xor(v, o);
    return v;
}
__device__ __forceinline__ float silu_f(float x) { return x / (1.f + __expf(-x)); }
#define LDS_FENCE() asm volatile("s_waitcnt lgkmcnt(0)" ::: "memory")

typedef __attribute__((address_space(4))) const unsigned char* kptr_t;
struct Ctx {
    kptr_t kp; unsigned char* lds;
    __device__ __forceinline__ int tid() const { return (int)threadIdx.x; }
    __device__ __forceinline__ int lane() const { return (int)threadIdx.x & 63; }
    __device__ __forceinline__ int wave() const { return __builtin_amdgcn_readfirstlane((int)threadIdx.x >> 6); }
    __device__ __forceinline__ int G_() const { return (int)gridDim.x; }
    __device__ __forceinline__ const float* in(int i) const { return *(const float* const __attribute__((address_space(4)))*)(kp + 8 * i); }
    __device__ __forceinline__ float* out_() const { return *(float* const __attribute__((address_space(4)))*)(kp + 144); }
    __device__ __forceinline__ unsigned char* ws_() const { return *(unsigned char* const __attribute__((address_space(4)))*)(kp + 152); }
    __device__ __forceinline__ const float* x_prompt() const { return in(0); }
    __device__ __forceinline__ const float* x_sample() const { return in(1); }
    __device__ __forceinline__ const float* st_conv() const { return in(2); }
    __device__ __forceinline__ const float* st_S() const { return in(3); }
    __device__ __forceinline__ const float* ck() const { return in(4); }
    __device__ __forceinline__ const float* cv() const { return in(5); }
    __device__ __forceinline__ const float* w_in() const { return in(6); }
    __device__ __forceinline__ const float* conv_w() const { return in(7); }
    __device__ __forceinline__ const float* a_log() const { return in(8); }
    __device__ __forceinline__ const float* dt_bias() const { return in(9); }
    __device__ __forceinline__ const float* gnorm_w() const { return in(10); }
    __device__ __forceinline__ const float* w_out() const { return in(11); }
    __device__ __forceinline__ const float* ln1_g() const { return in(12); }
    __device__ __forceinline__ const float* ln1_b() const { return in(13); }
    __device__ __forceinline__ const float* w_up() const { return in(14); }
    __device__ __forceinline__ const float* w_down() const { return in(15); }
    __device__ __forceinline__ const float* ln2_g() const { return in(16); }
    __device__ __forceinline__ const float* ln2_b() const { return in(17); }
    __device__ __forceinline__ bf16_t* WinT() const { return (bf16_t*)(ws_() + WS_WIN); }
    __device__ __forceinline__ bf16_t* WoutT() const { return (bf16_t*)(ws_() + WS_WOUT); }
    __device__ __forceinline__ bf16_t* WupT() const { return (bf16_t*)(ws_() + WS_WUP); }
    __device__ __forceinline__ bf16_t* WdnT() const { return (bf16_t*)(ws_() + WS_WDN); }
    __device__ __forceinline__ bf16_t* XB() const { return (bf16_t*)(ws_() + WS_XB); }
    __device__ __forceinline__ bf16_t* PROJ() const { return (bf16_t*)(ws_() + WS_PROJ); }
    __device__ __forceinline__ bf16_t* VT() const { return (bf16_t*)(ws_() + WS_VT); }
    __device__ __forceinline__ bf16_t* HB() const { return (bf16_t*)(ws_() + WS_H); }
    __device__ __forceinline__ bf16_t* NW() const { return (bf16_t*)(ws_() + WS_NW); }
    __device__ __forceinline__ bf16_t* QD() const { return (bf16_t*)(ws_() + WS_QD); }
    __device__ __forceinline__ bf16_t* KTT() const { return (bf16_t*)(ws_() + WS_KTT); }
    __device__ __forceinline__ bf16_t* ATT() const { return (bf16_t*)(ws_() + WS_ATT); }
    __device__ __forceinline__ bf16_t* MIX() const { return (bf16_t*)(ws_() + WS_MIX); }
    __device__ __forceinline__ float* BA() const { return (float*)(ws_() + WS_BA); }
    __device__ __forceinline__ float* U() const { return (float*)(ws_() + WS_U); }
    __device__ __forceinline__ float* GT() const { return (float*)(ws_() + WS_GT); }
    __device__ __forceinline__ float* OA() const { return (float*)(ws_() + WS_OA); }
    __device__ __forceinline__ float* PO() const { return (float*)(ws_() + WS_PO); }
    __device__ __forceinline__ float* PR() const { return (float*)(ws_() + WS_PR); }
    __device__ __forceinline__ bf16_t* Y1() const { return (bf16_t*)(ws_() + WS_Y1); }
    __device__ __forceinline__ float* X1() const { return (float*)(ws_() + WS_X1); }
    __device__ __forceinline__ bf16_t* Y2() const { return (bf16_t*)(ws_() + WS_Y2); }
    __device__ __forceinline__ float* PART1() const { return (float*)(ws_() + WS_PART1); }
    __device__ __forceinline__ float* PART2() const { return (float*)(ws_() + WS_PART2); }
    __device__ __forceinline__ float* out() const { return out_(); }
    __device__ __forceinline__ unsigned* ctl() const { return (unsigned*)(ws_() + WS_CTL); }
};

__device__ __forceinline__ void p0_transpose_item(const float* W, int ldw, int nblk, int K, bf16_t* WT, int row_off, float* scr, int item, int lane) {
    const int kb = item / nblk, nb = item % nblk, k0 = 64 * kb, n0 = 64 * nb;
    const int ks = lane >> 4, nq = lane & 15;
    f32x4 v[16];
#pragma unroll
    for (int i = 0; i < 16; ++i) v[i] = *(const f32x4*)(W + (size_t)(k0 + 4 * i + ks) * ldw + n0 + 4 * nq);
#pragma unroll
    for (int i = 0; i < 16; ++i) { float* d = scr + (4 * i + ks) * 65 + 4 * nq; d[0] = v[i][0]; d[1] = v[i][1]; d[2] = v[i][2]; d[3] = v[i][3]; }
    LDS_FENCE();
    const int c = lane & 7;
#pragma unroll
    for (int j = 0; j < 8; ++j) { const int n = (lane >> 3) + 8 * j; const float* s = scr + (8 * c) * 65 + n;
        u32x4 o; o.x = pk2(s[0 * 65], s[1 * 65]); o.y = pk2(s[2 * 65], s[3 * 65]); o.z = pk2(s[4 * 65], s[5 * 65]); o.w = pk2(s[6 * 65], s[7 * 65]);
        *(u32x4*)(WT + (size_t)(row_off + n0 + n) * K + k0 + 8 * c) = o; }
    LDS_FENCE();
}
__device__ __forceinline__ void p0_load_x(f32x4 (&v)[8], Ctx& F, int m, int lane) {
    const float* xr = (m < MP) ? F.x_prompt() + (size_t)m * DM : F.x_sample() + (size_t)(m - MP) * DM;
#pragma unroll
    for (int j = 0; j < 8; ++j) v[j] = ((const f32x4*)xr)[64 * j + lane];
}
constexpr int I_IN1 = 32 * 64, I_IN2 = 32 * 48, I_OUT = 32 * 32, I_UP = 32 * 128, I_DN = 128 * 32;
constexpr int NT_EARLY = I_IN1 + I_IN2, NT_LATE = I_OUT + I_UP + I_DN;
__device__ __forceinline__ void p0_transpose_any(Ctx& F, int it, float* scr) {
    int r = it; const float* W; int ldw, nblk, K, roff; bf16_t* WT;
    if (r < I_IN1) { W = F.w_in(); ldw = 7184; nblk = 64; K = DM; WT = F.WinT(); roff = 0; }
    else if ((r -= I_IN1) < I_IN2) { W = F.w_in() + 4112; ldw = 7184; nblk = 48; K = DM; WT = F.WinT(); roff = 4096; }
    else if ((r -= I_IN2) < I_OUT) { W = F.w_out(); ldw = DM; nblk = 32; K = DM; WT = F.WoutT(); roff = 0; }
    else if ((r -= I_OUT) < I_UP) { W = F.w_up(); ldw = FF; nblk = 128; K = DM; WT = F.WupT(); roff = 0; }
    else { r -= I_UP; W = F.w_down(); ldw = DM; nblk = 32; K = FF; WT = F.WdnT(); roff = 0; }
    p0_transpose_item(W, ldw, nblk, K, WT, roff, scr, r, F.lane());
}
__device__ __forceinline__ void p0_prologue(Ctx& F) {
    float* scr = (float*)(F.lds + F.wave() * 16640);
    const int gw = blockIdx.x * 8 + F.wave(), NGW = F.G_() * 8;
    for (int it = gw; it < NT_EARLY; it += NGW) p0_transpose_any(F, it, scr);
    __syncthreads();
    float* wT = (float*)F.lds;
    for (int k = F.tid(); k < DM; k += 512) {
        const float* src = F.w_in() + (size_t)k * 7184 + 4096;
#pragma unroll
        for (int q = 0; q < 4; ++q) { const f32x4 v = *(const f32x4*)(src + 4 * q); wT[(4 * q + 0) * DM + k] = v[0]; wT[(4 * q + 1) * DM + k] = v[1]; wT[(4 * q + 2) * DM + k] = v[2]; wT[(4 * q + 3) * DM + k] = v[3]; }
    }
    __syncthreads();
    f32x4 nv[8];
    if (gw < MT) p0_load_x(nv, F, gw, F.lane());
    for (int m = gw; m < MT; m += NGW) {
        f32x4 v[8];
#pragma unroll
        for (int j = 0; j < 8; ++j) v[j] = nv[j];
        if (m + NGW < MT) p0_load_x(nv, F, m + NGW, F.lane());
        bf16_t* xb = F.XB() + (size_t)m * DM;
#pragma unroll
        for (int j = 0; j < 8; ++j) { u32x2 o; o.x = pk2(v[j][0], v[j][1]); o.y = pk2(v[j][2], v[j][3]); *(u32x2*)(xb + 256 * j + 4 * F.lane()) = o; }
        float mine = 0.f;
#pragma unroll
        for (int c = 0; c < 16; ++c) {
            float s = 0.f;
#pragma unroll
            for (int j = 0; j < 8; ++j) { const f32x4 w = *(const f32x4*)(wT + c * DM + 256 * j + 4 * F.lane()); s += v[j][0] * w[0] + v[j][1] * w[1] + v[j][2] * w[2] + v[j][3] * w[3]; }
            s = wave_sum(s);
            if (F.lane() == c) mine = s;
        }
        if (F.lane() < 16) F.BA()[(size_t)m * 16 + F.lane()] = mine;
    }
}

constexpr int PL_KN = 0, PL_QN = 17408, PL_VBT = 34816, PL_KBGT = 53248, PL_KTT = 71680, PL_MM = 90112, PL_TB = 107520, PL_SM = 116736;
template <int C> __device__ __forceinline__ void gdn_prep(Ctx& F, bool sample, int b, int h, int n, int chunk) {
    bf16_t* KN = (bf16_t*)(F.lds + PL_KN); bf16_t* QN = (bf16_t*)(F.lds + PL_QN); bf16_t* VBt = (bf16_t*)(F.lds + PL_VBT); bf16_t* KBGt = (bf16_t*)(F.lds + PL_KBGT);
    bf16_t* KTt = (bf16_t*)(F.lds + PL_KTT); float* MM = (float*)(F.lds + PL_MM); bf16_t* Tb = (bf16_t*)(F.lds + PL_TB);
    float* s_beta = (float*)(F.lds + PL_SM); float* s_gc = s_beta + 64; float* s_egc = s_beta + 128;
    const int lane = F.lane(), wave = F.wave(), tid = F.tid(), fr = lane & 15, g = lane >> 4;
    const int seqrow = sample ? MP + b * DSEQ : b * SEQ;
    const int tpos0 = n * C;
    const int m0 = seqrow + tpos0;
    if (wave == 0) {
        float beta = 0.f, gg = 0.f;
        if (lane < C) {
            const float bl = F.BA()[(size_t)(m0 + lane) * 16 + h], al = F.BA()[(size_t)(m0 + lane) * 16 + 8 + h];
            beta = 1.f / (1.f + expf(-bl));
            const float xx = al + F.dt_bias()[h];
            const float sp = xx > 20.f ? xx : log1pf(expf(xx));
            gg = -expf(F.a_log()[h]) * sp;
        }
        float gc = gg;
#pragma unroll
        for (int o = 1; o < 64; o <<= 1) { const float t = __shfl_up(gc, o); if (lane >= o) gc += t; }
        if (lane < C) { s_beta[lane] = beta; s_gc[lane] = gc; s_egc[lane] = expf(gc); }
    }
    __syncthreads();
    const float gcl = s_gc[C - 1];
    {
        constexpr int TPW = C / 8, NRW = TPW + 3;
        float u0[3][NRW], u1[3][NRW];
#pragma unroll
        for (int which = 0; which < 3; ++which) {
            const int col = which * 1024 + h * 128 + 2 * lane;
#pragma unroll
            for (int r = 0; r < NRW; ++r) {
                const int pos = tpos0 + TPW * wave - 3 + r;
                if (pos >= 0) { const unsigned pk = *(const unsigned*)(F.PROJ() + (size_t)(seqrow + pos) * NP + col); u0[which][r] = bflo(pk); u1[which][r] = bfhi(pk); }
                else if (sample) { const float* s = F.st_conv() + (size_t)(b * 3 + pos + 3) * 3072 + col; u0[which][r] = s[0]; u1[which][r] = s[1]; }
                else { u0[which][r] = 0.f; u1[which][r] = 0.f; }
            }
        }
#pragma unroll
        for (int which = 0; which < 3; ++which) {
            const int col = which * 1024 + h * 128 + 2 * lane;
            float cw0[4], cw1[4];
#pragma unroll
            for (int i = 0; i < 4; ++i) { cw0[i] = F.conv_w()[i * 3072 + col]; cw1[i] = F.conv_w()[i * 3072 + col + 1]; }
#pragma unroll
            for (int tt = 0; tt < TPW; ++tt) {
                const int t = TPW * wave + tt;
                float x0 = 0.f, x1 = 0.f;
#pragma unroll
                for (int i = 0; i < 4; ++i) { x0 += cw0[i] * u0[which][tt + i]; x1 += cw1[i] * u1[which][tt + i]; }
                x0 = silu_f(x0); x1 = silu_f(x1);
                const float bt = s_beta[t], egc = s_egc[t];
                if (which == 0) {
                    const float rs = rsqrtf(wave_sum(x0 * x0 + x1 * x1) + L2_EPS);
                    x0 *= rs; x1 *= rs;
                    *(unsigned*)(QN + t * 136 + 2 * lane) = pk2(x0, x1);
                    const float f = QSCALE * egc;
                    *(unsigned*)(F.QD() + (size_t)chunk * 8192 + t * 128 + 2 * lane) = pk2(x0 * f, x1 * f);
                } else if (which == 1) {
                    const float rs = rsqrtf(wave_sum(x0 * x0 + x1 * x1) + L2_EPS);
                    x0 *= rs; x1 *= rs;
                    *(unsigned*)(KN + t * 136 + 2 * lane) = pk2(x0, x1);
                    const float f = bt * egc, f2 = expf(gcl - s_gc[t]);
                    KBGt[(2 * lane) * 72 + t] = (bf16_t)f2bf(x0 * f); KBGt[(2 * lane + 1) * 72 + t] = (bf16_t)f2bf(x1 * f);
                    KTt[(2 * lane) * 72 + t] = (bf16_t)f2bf(x0 * f2); KTt[(2 * lane + 1) * 72 + t] = (bf16_t)f2bf(x1 * f2);
                } else {
                    VBt[(2 * lane) * 72 + t] = (bf16_t)f2bf(x0 * bt); VBt[(2 * lane + 1) * 72 + t] = (bf16_t)f2bf(x1 * bt);
                }
            }
        }
    }
    __syncthreads();
    constexpr int NT = C / 16;
    for (int tile = wave; tile < NT * NT; tile += 8) {
        const int it = tile / NT, jt = tile % NT;
        f32x4 akk = {0.f, 0.f, 0.f, 0.f}, aqk = {0.f, 0.f, 0.f, 0.f};
#pragma unroll
        for (int ks = 0; ks < 4; ++ks) {
            const bf16x8 ki = *(const bf16x8*)(KN + (16 * it + fr) * 136 + 32 * ks + 8 * g);
            const bf16x8 kj = *(const bf16x8*)(KN + (16 * jt + fr) * 136 + 32 * ks + 8 * g);
            const bf16x8 qi = *(const bf16x8*)(QN + (16 * it + fr) * 136 + 32 * ks + 8 * g);
            akk = mfma16(ki, kj, akk);
            aqk = mfma16(kj, qi, aqk);
        }
        {   const int j = 16 * jt + fr; const float gj = s_gc[j];
#pragma unroll
            for (int jj = 0; jj < 4; ++jj) { const int i = 16 * it + 4 * g + jj; MM[i * 68 + j] = (i > j) ? s_beta[i] * akk[jj] * __expf(s_gc[i] - gj) : 0.f; } }
        {   const int i = 16 * it + fr; const float gi = s_gc[i]; float v[4];
#pragma unroll
            for (int jj = 0; jj < 4; ++jj) { const int j = 16 * jt + 4 * g + jj; v[jj] = (i >= j) ? aqk[jj] * QSCALE * __expf(gi - s_gc[j]) : 0.f; }
            u32x2 o; o.x = pk2(v[0], v[1]); o.y = pk2(v[2], v[3]);
            *(u32x2*)(F.ATT() + (size_t)chunk * 4096 + i * C + 16 * jt + 4 * g) = o; }
    }
    __syncthreads();
    if (wave == 0) {
        float tc[C];
        const float* MMv = MM; asm volatile("" : "+v"(MMv));
#pragma unroll
        for (int i = 0; i < C; ++i) {
            float a0 = (i == lane) ? 1.f : 0.f, a1 = 0.f, a2 = 0.f, a3 = 0.f;
#pragma unroll
            for (int j4 = 0; j4 < i; j4 += 4) {
                const f32x4 mv = *(const f32x4*)(MMv + i * 68 + j4);
                a0 -= mv[0] * tc[j4];
                if (j4 + 1 < i) a1 -= mv[1] * tc[j4 + 1];
                if (j4 + 2 < i) a2 -= mv[2] * tc[j4 + 2];
                if (j4 + 3 < i) a3 -= mv[3] * tc[j4 + 3];
            }
            tc[i] = (a0 + a1) + (a2 + a3);
        }
        if (lane < C) {
#pragma unroll
            for (int i = 0; i < C; ++i) Tb[i * 72 + lane] = (bf16_t)f2bf(tc[i]);
        }
    }
    __syncthreads();
    for (int job = wave; job < 2 * 8 * NT; job += 8) {
        const int mat = job / (8 * NT), dt = (job / NT) % 8, it = job % NT;
        const bf16_t* X = mat ? KBGt : VBt;
        f32x4 acc = {0.f, 0.f, 0.f, 0.f};
#pragma unroll
        for (int ks = 0; ks < C / 32; ++ks) {
            const bf16x8 a = *(const bf16x8*)(X + (16 * dt + fr) * 72 + 32 * ks + 8 * g);
            const bf16x8 bb = *(const bf16x8*)(Tb + (16 * it + fr) * 72 + 32 * ks + 8 * g);
            acc = mfma16(a, bb, acc);
        }
        const int i = 16 * it + fr, d0 = 16 * dt + 4 * g;
        if (mat == 0) *(f32x4*)(F.U() + (size_t)chunk * 8192 + i * 128 + d0) = acc;
        else { u32x2 o; o.x = pk2(-acc[0], -acc[1]); o.y = pk2(-acc[2], -acc[3]); *(u32x2*)(F.NW() + (size_t)chunk * 8192 + i * 128 + d0) = o; }
    }
    for (int idx = tid; idx < 128 * (C / 8); idx += 512) {
        const int d = idx / (C / 8), c8 = idx % (C / 8);
        *(u32x4*)(F.KTT() + (size_t)chunk * 8192 + d * C + c8 * 8) = *(const u32x4*)(KTt + d * 72 + c8 * 8);
    }
    if (tid == 0) F.GT()[chunk * 32] = expf(gcl);
    __syncthreads();
}
__device__ __forceinline__ void vt_item(Ctx& F, int wi) {
    bf16_t* tile = (bf16_t*)(F.lds + F.wave() * 8448);
    const int m0 = 64 * (wi >> 4), f0 = 64 * (wi & 15), lane = F.lane();
#pragma unroll 8
    for (int r = 0; r < 64; ++r) tile[r * 66 + lane] = F.PROJ()[(size_t)(m0 + r) * NP + 6144 + f0 + lane];
    LDS_FENCE();
#pragma unroll 8
    for (int f = 0; f < 64; ++f) F.VT()[(size_t)(f0 + f) * MT + m0 + lane] = tile[lane * 66 + f];
    LDS_FENCE();
}
__device__ __forceinline__ void p2_prep(Ctx& F) {
    constexpr int N_VT = (MT / 64) * 16 / 8;
    for (int it = blockIdx.x; it < NCH + N_VT; it += F.G_()) {
        if (it < NCH_P) { const int b = it >> 8, h = (it >> 5) & 7, n = it & 31; gdn_prep<64>(F, false, b, h, n, it); }
        else if (it < NCH) { const int bh = it - NCH_P; gdn_prep<32>(F, true, bh >> 3, bh & 7, 0, it); }
        else { vt_item(F, (it - NCH) * 8 + F.wave()); __syncthreads(); }
    }
}

constexpr int SL_ST = 0, SL_VN = 8704;
template <int C> struct ScanOps { bf16x8 bw[4], bq[4], ba[C / 32], bk[2][C / 32]; f32x4 u; float gt; };
template <int C> __device__ __forceinline__ void scan_load(Ctx& F, ScanOps<C>& o, int chunk, bool act, int c, int sl, int mt, int nt0, int fr, int g) {
    const bf16_t* NWc = F.NW() + (size_t)chunk * 8192; const bf16_t* QDc = F.QD() + (size_t)chunk * 8192;
    const bf16_t* ATc = F.ATT() + (size_t)chunk * 4096; const bf16_t* KTc = F.KTT() + (size_t)chunk * 8192; const float* Uc = F.U() + (size_t)chunk * 8192;
    o.gt = F.GT()[chunk * 32];
    if (act) {
        o.u = *(const f32x4*)(Uc + c * 128 + 32 * sl + 16 * mt + 4 * g);
#pragma unroll
        for (int ks = 0; ks < 4; ++ks) { o.bw[ks] = *(const bf16x8*)(NWc + c * 128 + 32 * ks + 8 * g); o.bq[ks] = *(const bf16x8*)(QDc + c * 128 + 32 * ks + 8 * g); }
#pragma unroll
        for (int ks = 0; ks < C / 32; ++ks) o.ba[ks] = *(const bf16x8*)(ATc + c * C + 32 * ks + 8 * g);
    }
#pragma unroll
    for (int i = 0; i < 2; ++i)
#pragma unroll
        for (int ks = 0; ks < C / 32; ++ks) o.bk[i][ks] = *(const bf16x8*)(KTc + (16 * (nt0 + i) + fr) * C + 32 * ks + 8 * g);
}
template <int C> __device__ __forceinline__ void scan_step(Ctx& F, ScanOps<C>& o, bool reload, int cnext, f32x4 (&accS)[2], bf16_t* St, bf16_t* VNt, bool act, int c, int row, int h, int sl, int mt, int nt0, int fr, int g) {
    f32x4 accV = {0.f, 0.f, 0.f, 0.f}, accO = {0.f, 0.f, 0.f, 0.f};
    const float gt = o.gt;
    if (act) {
        accV = o.u;
#pragma unroll
        for (int ks = 0; ks < 4; ++ks) {
            const bf16x8 a = *(const bf16x8*)(St + (16 * mt + fr) * 136 + 32 * ks + 8 * g);
            accV = mfma16(a, o.bw[ks], accV);
            accO = mfma16(a, o.bq[ks], accO);
        }
        if (reload) {
            const bf16_t* NWc = F.NW() + (size_t)cnext * 8192; const bf16_t* QDc = F.QD() + (size_t)cnext * 8192;
            o.u = *(const f32x4*)(F.U() + (size_t)cnext * 8192 + c * 128 + 32 * sl + 16 * mt + 4 * g);
#pragma unroll
            for (int ks = 0; ks < 4; ++ks) { o.bw[ks] = *(const bf16x8*)(NWc + c * 128 + 32 * ks + 8 * g); o.bq[ks] = *(const bf16x8*)(QDc + c * 128 + 32 * ks + 8 * g); }
        }
#pragma unroll
        for (int jj = 0; jj < 4; ++jj) VNt[(16 * mt + 4 * g + jj) * 72 + c] = (bf16_t)f2bf(accV[jj]);
    }
    __syncthreads();
    if (act) {
#pragma unroll
        for (int ks = 0; ks < C / 32; ++ks) {
            const bf16x8 a = *(const bf16x8*)(VNt + (16 * mt + fr) * 72 + 32 * ks + 8 * g);
            accO = mfma16(a, o.ba[ks], accO);
        }
        if (reload) {
#pragma unroll
            for (int ks = 0; ks < C / 32; ++ks) o.ba[ks] = *(const bf16x8*)(F.ATT() + (size_t)cnext * 4096 + c * C + 32 * ks + 8 * g);
        }
        *(f32x4*)(F.OA() + (size_t)row * 1024 + h * 128 + 32 * sl + 16 * mt + 4 * g) = accO;
    }
#pragma unroll
    for (int i = 0; i < 2; ++i) {
        accS[i] = accS[i] * gt;
        const int d = 16 * (nt0 + i) + fr;
#pragma unroll
        for (int ks = 0; ks < C / 32; ++ks) {
            const bf16x8 a = *(const bf16x8*)(VNt + (16 * mt + fr) * 72 + 32 * ks + 8 * g);
            accS[i] = mfma16(a, o.bk[i][ks], accS[i]);
        }
        if (reload) {
#pragma unroll
            for (int ks = 0; ks < C / 32; ++ks) o.bk[i][ks] = *(const bf16x8*)(F.KTT() + (size_t)cnext * 8192 + d * C + 32 * ks + 8 * g);
        }
#pragma unroll
        for (int jj = 0; jj < 4; ++jj) St[(16 * mt + 4 * g + jj) * 136 + d] = (bf16_t)f2bf(accS[i][jj]);
    }
    if (reload) o.gt = F.GT()[cnext * 32];
    __syncthreads();
}
template <int C> __device__ __forceinline__ void gdn_scan(Ctx& F, int chunk0, int nsteps, int m0, int h, int sl, const float* S0, float* Sout) {
    bf16_t* St = (bf16_t*)(F.lds + SL_ST); bf16_t* VNt = (bf16_t*)(F.lds + SL_VN);
    const int lane = F.lane(), wave = F.wave(), fr = lane & 15, g = lane >> 4;
    const int mt = wave & 1, ct = wave >> 1, nt0 = (wave >> 1) * 2;
    const bool act = ct < C / 16;
    const int c = 16 * ct + fr;
    ScanOps<C> A, B;
    scan_load<C>(F, A, chunk0, act, c, sl, mt, nt0, fr, g);
    if (nsteps > 1) scan_load<C>(F, B, chunk0 + 1, act, c, sl, mt, nt0, fr, g);
    f32x4 accS[2];
#pragma unroll
    for (int i = 0; i < 2; ++i) {
        const int d = 16 * (nt0 + i) + fr;
        accS[i] = S0 ? *(const f32x4*)(S0 + (size_t)d * 128 + 32 * sl + 16 * mt + 4 * g) : (f32x4){0.f, 0.f, 0.f, 0.f};
    }
    __syncthreads();
#pragma unroll
    for (int i = 0; i < 2; ++i)
#pragma unroll
        for (int jj = 0; jj < 4; ++jj) St[(16 * mt + 4 * g + jj) * 136 + 16 * (nt0 + i) + fr] = (bf16_t)f2bf(accS[i][jj]);
    __syncthreads();
    for (int s = 0; s < nsteps; s += 2) {
        scan_step<C>(F, A, s + 2 < nsteps, chunk0 + s + 2, accS, St, VNt, act, c, m0 + s * C + c, h, sl, mt, nt0, fr, g);
        if (s + 1 >= nsteps) break;
        scan_step<C>(F, B, s + 3 < nsteps, chunk0 + s + 3, accS, St, VNt, act, c, m0 + (s + 1) * C + c, h, sl, mt, nt0, fr, g);
    }
#pragma unroll
    for (int i = 0; i < 2; ++i) { const int d = 16 * (nt0 + i) + fr; *(f32x4*)(Sout + (size_t)d * 128 + 32 * sl + 16 * mt + 4 * g) = accS[i]; }
}

struct SbState { bf16x8 qf[4]; f32x4 oacc[8]; float R; };
constexpr int AL_K = 0, AL_V = 17408;
template <bool F32SRC> __device__ __forceinline__ void sb_tiles(Ctx& F, SbState& st, bool act, int qpos, int mask_from, int t_lo, int t_hi, int seq_len,
                                                               const bf16_t* kb, const bf16_t* vt, const float* kf, const float* vf) {
    bf16_t* Ks = (bf16_t*)(F.lds + AL_K); bf16_t* Vts = (bf16_t*)(F.lds + AL_V);
    const int lane = F.lane(), tid = F.tid(), fr = lane & 15, g = lane >> 4;
    constexpr int NR = F32SRC ? 4 : 2;
    u32x4 kreg[NR], vreg[NR];
#define SB_LOAD(t) do { _Pragma("unroll") for (int it_ = 0; it_ < 2; ++it_) { const int idx_ = tid + 512 * it_; \
        if (F32SRC) { const int row_ = idx_ >> 4, cc_ = idx_ & 15; const float* s_ = kf + (size_t)((t) * 64 + row_) * 1024 + cc_ * 8; \
            kreg[2 * it_] = *(const u32x4*)s_; kreg[2 * it_ + 1] = *(const u32x4*)(s_ + 4); \
            const int key_ = idx_ & 63, c2_ = idx_ >> 6; const float* v_ = vf + (size_t)((t) * 64 + key_) * 1024 + c2_ * 8; \
            vreg[2 * it_] = *(const u32x4*)v_; vreg[2 * it_ + 1] = *(const u32x4*)(v_ + 4); } \
        else { const int row_ = idx_ >> 4, cc_ = idx_ & 15; const int key_ = (t) * 64 + row_; \
            kreg[it_] = (key_ < seq_len) ? *(const u32x4*)(kb + (size_t)key_ * NP + cc_ * 8) : (u32x4){0u, 0u, 0u, 0u}; \
            const int d_ = idx_ >> 3, c8_ = idx_ & 7; const int tok_ = (t) * 64 + c8_ * 8; \
            vreg[it_] = (tok_ < seq_len) ? *(const u32x4*)(vt + (size_t)d_ * MT + tok_) : (u32x4){0u, 0u, 0u, 0u}; } } } while (0)
#define SB_STORE() do { _Pragma("unroll") for (int it_ = 0; it_ < 2; ++it_) { const int idx_ = tid + 512 * it_; \
        if (F32SRC) { const int row_ = idx_ >> 4, cc_ = idx_ & 15; const u32x4 a_ = kreg[2 * it_], b_ = kreg[2 * it_ + 1]; u32x4 o_; \
            o_.x = pk2(asf(a_.x), asf(a_.y)); o_.y = pk2(asf(a_.z), asf(a_.w)); \
            o_.z = pk2(asf(b_.x), asf(b_.y)); o_.w = pk2(asf(b_.z), asf(b_.w)); \
            *(u32x4*)(Ks + row_ * 136 + cc_ * 8) = o_; \
            const int key_ = idx_ & 63, c2_ = idx_ >> 6; const u32x4 c_ = vreg[2 * it_], d2_ = vreg[2 * it_ + 1]; \
            Vts[(c2_ * 8 + 0) * 72 + key_] = (bf16_t)f2bf(asf(c_.x)); Vts[(c2_ * 8 + 1) * 72 + key_] = (bf16_t)f2bf(asf(c_.y)); \
            Vts[(c2_ * 8 + 2) * 72 + key_] = (bf16_t)f2bf(asf(c_.z)); Vts[(c2_ * 8 + 3) * 72 + key_] = (bf16_t)f2bf(asf(c_.w)); \
            Vts[(c2_ * 8 + 4) * 72 + key_] = (bf16_t)f2bf(asf(d2_.x)); Vts[(c2_ * 8 + 5) * 72 + key_] = (bf16_t)f2bf(asf(d2_.y)); \
            Vts[(c2_ * 8 + 6) * 72 + key_] = (bf16_t)f2bf(asf(d2_.z)); Vts[(c2_ * 8 + 7) * 72 + key_] = (bf16_t)f2bf(asf(d2_.w)); } \
        else { const int row_ = idx_ >> 4, cc_ = idx_ & 15; *(u32x4*)(Ks + row_ * 136 + cc_ * 8) = kreg[it_]; \
            const int d_ = idx_ >> 3, c8_ = idx_ & 7; *(u32x4*)(Vts + d_ * 72 + c8_ * 8) = vreg[it_]; } } } while (0)
    if (!__syncthreads_or(act && st.R != 0.f)) return;
    SB_LOAD(t_hi - 1);
    for (int t = t_hi - 1; t >= t_lo; --t) {
        if (t != t_hi - 1 && !__syncthreads_or(act && st.R != 0.f)) break;
        SB_STORE();
        __syncthreads();
        if (t > t_lo) SB_LOAD(t - 1);
        if (act) {
            f32x4 sc[4];
#pragma unroll
            for (int mt = 0; mt < 4; ++mt) {
                sc[mt] = (f32x4){0.f, 0.f, 0.f, 0.f};
#pragma unroll
                for (int ks = 0; ks < 4; ++ks) sc[mt] = mfma16(*(const bf16x8*)(Ks + (16 * mt + fr) * 136 + 32 * ks + 8 * g), st.qf[ks], sc[mt]);
            }
            const bool masked = t >= mask_from;
            float wt[4][4], T[4], PH[4];
            const float cexp = QSCALE * 1.4426950408889634f;
#pragma unroll
            for (int mt = 0; mt < 4; ++mt) {
                float om[4];
#pragma unroll
                for (int jj = 0; jj < 4; ++jj) {
                    const float x = fminf(sc[mt][jj] * cexp, 100.f);
                    const float e = __builtin_amdgcn_exp2f(x);
                    const float r = __builtin_amdgcn_rcpf(1.f + e);
                    float bt = e * r, o1 = r;
                    if (masked) { const bool valid = (t * 64 + 16 * mt + 4 * g + jj) < qpos; bt = valid ? bt : 0.f; o1 = valid ? o1 : 1.f; }
                    wt[mt][jj] = bt; om[jj] = o1;
                }
                const float e2 = om[3], e1 = om[3] * om[2], e0 = e1 * om[1], G = e0 * om[0];
                wt[mt][3] *= 1.f; wt[mt][2] *= e2; wt[mt][1] *= e1; wt[mt][0] *= e0;
                const float y1 = __shfl_xor(G, 16), y2 = __shfl_xor(G, 32), y3 = __shfl_xor(G, 48);
                T[mt] = G * y1 * y2 * y3;
                PH[mt] = (((g ^ 1) > g) ? y1 : 1.f) * (((g ^ 2) > g) ? y2 : 1.f) * (((g ^ 3) > g) ? y3 : 1.f);
            }
            float suf = st.R;
#pragma unroll
            for (int mt = 3; mt >= 0; --mt) {
                const float f = suf * PH[mt];
#pragma unroll
                for (int jj = 0; jj < 4; ++jj) wt[mt][jj] *= f;
                suf *= T[mt];
            }
            st.R = suf;
            bf16x8 pf[2];
#pragma unroll
            for (int s = 0; s < 2; ++s) {
                u32x4 p; p.x = pk2(wt[2 * s][0], wt[2 * s][1]); p.y = pk2(wt[2 * s][2], wt[2 * s][3]); p.z = pk2(wt[2 * s + 1][0], wt[2 * s + 1][1]); p.w = pk2(wt[2 * s + 1][2], wt[2 * s + 1][3]);
                pf[s] = __builtin_bit_cast(bf16x8, p);
            }
#pragma unroll
            for (int dt = 0; dt < 8; ++dt)
#pragma unroll
                for (int s = 0; s < 2; ++s) {
                    const bf16_t* vp = Vts + (16 * dt + fr) * 72 + 32 * s + 4 * g;
                    const u32x2 lo = *(const u32x2*)vp, hi = *(const u32x2*)(vp + 16);
                    const u32x4 a = {lo.x, lo.y, hi.x, hi.y};
                    st.oacc[dt] = mfma16(__builtin_bit_cast(bf16x8, a), pf[s], st.oacc[dt]);
                }
        }
    }
#undef SB_LOAD
#undef SB_STORE
}
__device__ __forceinline__ void sb_init(Ctx& F, SbState& st, bool act, const bf16_t* q) {
    const int lane = F.lane(), wave = F.wave(), fr = lane & 15, g = lane >> 4;
#pragma unroll
    for (int ks = 0; ks < 4; ++ks) st.qf[ks] = act ? *(const bf16x8*)(q + (size_t)(16 * wave + fr) * NP + 32 * ks + 8 * g) : (bf16x8){0, 0, 0, 0, 0, 0, 0, 0};
#pragma unroll
    for (int dt = 0; dt < 8; ++dt) st.oacc[dt] = (f32x4){0.f, 0.f, 0.f, 0.f};
    st.R = 1.f;
}
__device__ __forceinline__ void sb_store(Ctx& F, const SbState& st, bool act, bf16_t* o_bf) {
    const int lane = F.lane(), wave = F.wave(), fr = lane & 15, g = lane >> 4;
    if (act) {
        const int qi = 16 * wave + fr;
#pragma unroll
        for (int dt = 0; dt < 8; ++dt) { u32x2 o; o.x = pk2(st.oacc[dt][0], st.oacc[dt][1]); o.y = pk2(st.oacc[dt][2], st.oacc[dt][3]); *(u32x2*)(o_bf + (size_t)qi * DM + 16 * dt + 4 * g) = o; }
    }
}

constexpr int Q3_SCANP = 128, Q3_SBP = Q3_SCANP + 512, Q3_SBS = Q3_SBP + 128, Q3_SCANS = Q3_SBS + 512;
constexpr int LT_P1 = 72 * 8 * 6;
__device__ __forceinline__ void p3_mix(Ctx& F) {
    volatile int* slot = (volatile int*)(F.lds + LDS_BYTES - 64);
    unsigned* ctr = F.ctl() + 64;
    const bool shared = (F.G_() == 256);
    const int lt0 = shared ? LT_P1 : 0, lt1 = shared ? I_OUT + I_UP : NT_LATE, q3_end = Q3_SCANS + (lt1 - lt0) / 8;
    for (;;) {
        __syncthreads();
        if (F.tid() == 0) *slot = (int)atomicAdd(ctr, 1u);
        __syncthreads();
        const int it = *slot;
        if (it >= q3_end) break;
        if (it < Q3_SCANP) {
            const int b = it >> 5, h = (it >> 2) & 7, sl = it & 3;
            gdn_scan<64>(F, (b * 8 + h) * 32, 32, b * SEQ, h, sl, nullptr, F.out() + OUT_SP + (size_t)(b * 8 + h) * 16384);
        } else if (it < Q3_SBP) {
            const int idx = it - Q3_SCANP, qb = 15 - (idx >> 5), bh = idx & 31, b = bh >> 3, h = bh & 7;
            const int qrow = b * SEQ + 128 * qb; const int wave = F.wave(), fr = F.lane() & 15;
            SbState st; sb_init(F, st, true, F.PROJ() + (size_t)qrow * NP + 4096 + h * 128);
            sb_tiles<false>(F, st, true, 128 * qb + 16 * wave + fr, 2 * qb, 0, 2 * qb + 2, SEQ,
                            F.PROJ() + (size_t)(b * SEQ) * NP + 5120 + h * 128, F.VT() + (size_t)(h * 128) * MT + b * SEQ, nullptr, nullptr);
            sb_store(F, st, true, F.MIX() + (size_t)qrow * DM + 1024 + h * 128);
        } else if (it < Q3_SBS) {
            const int bh = it - Q3_SBP, b = bh >> 3, h = bh & 7;
            const int qrow = MP + b * DSEQ; const int wave = F.wave(), fr = F.lane() & 15; const bool act = wave < 2;
            SbState st; sb_init(F, st, act, F.PROJ() + (size_t)qrow * NP + 4096 + h * 128);
            sb_tiles<false>(F, st, act, 16 * wave + fr, 0, 0, 1, DSEQ,
                            F.PROJ() + (size_t)qrow * NP + 5120 + h * 128, F.VT() + (size_t)(h * 128) * MT + qrow, nullptr, nullptr);
            sb_tiles<true>(F, st, act, 0, 1 << 30, 0, PAST / 64, PAST, nullptr, nullptr,
                           F.ck() + ((size_t)b * PAST * NH + h) * HD, F.cv() + ((size_t)b * PAST * NH + h) * HD);
            sb_store(F, st, act, F.MIX() + (size_t)qrow * DM + 1024 + h * 128);
        } else if (it < Q3_SCANS) {
            const int idx = it - Q3_SBS, bh = idx >> 2, sl = idx & 3, b = bh >> 3, h = bh & 7;
            gdn_scan<32>(F, NCH_P + bh, 1, MP + b * DSEQ, h, sl, F.st_S() + (size_t)bh * 16384, F.out() + OUT_SS + (size_t)bh * 16384);
        } else {
            p0_transpose_any(F, NT_EARLY + lt0 + (it - Q3_SCANS) * 8 + F.wave(), (float*)(F.lds + F.wave() * 16640));
        }
    }
}

__device__ __forceinline__ void p4_finalize(Ctx& F) {
    const int gw = blockIdx.x * 8 + F.wave(), NGW = F.G_() * 8, lane = F.lane();
    const float nw0 = F.gnorm_w()[2 * lane], nw1 = F.gnorm_w()[2 * lane + 1];
    for (int m = gw; m < MT; m += NGW) {
        float2 o[8]; unsigned zp[8];
#pragma unroll
        for (int h = 0; h < 8; ++h) { o[h] = *(const float2*)(F.OA() + (size_t)m * 1024 + h * 128 + 2 * lane); zp[h] = *(const unsigned*)(F.PROJ() + (size_t)m * NP + 3072 + h * 128 + 2 * lane); }
#pragma unroll
        for (int h = 0; h < 8; ++h) {
            const float rs = rsqrtf(wave_sum(o[h].x * o[h].x + o[h].y * o[h].y) * (1.f / 128.f) + RMS_EPS);
            *(unsigned*)(F.MIX() + (size_t)m * DM + h * 128 + 2 * lane) = pk2(o[h].x * rs * nw0 * silu_f(bflo(zp[h])), o[h].y * rs * nw1 * silu_f(bfhi(zp[h])));
        }
    }
}

template <int NSPLIT, bool RB> __device__ __forceinline__ void ln_load_row(f32x4 (&v)[8], int m, int lane, const bf16_t* Y, const float* part, const void* res_s) {
    if (m < MP) {
        const u32x2* yr = (const u32x2*)(Y + (size_t)m * DM);
#pragma unroll
        for (int j = 0; j < 8; ++j) { const u32x2 w = __builtin_nontemporal_load(yr + 64 * j + lane); const unsigned wx = w.x, wy = w.y; v[j][0] = bflo(wx); v[j][1] = bfhi(wx); v[j][2] = bflo(wy); v[j][3] = bfhi(wy); }
    } else {
#pragma unroll
        for (int j = 0; j < 8; ++j) {
            u32x2 p[NSPLIT];
#pragma unroll
            for (int sp = 0; sp < NSPLIT; ++sp) p[sp] = ((const u32x2*)((const bf16_t*)part + ((size_t)sp * 512 + (m - MP)) * DM))[64 * j + lane];
            f32x4 a;
            if (RB) { const u32x2 w = ((const u32x2*)((const bf16_t*)res_s + (size_t)(m - MP) * DM))[64 * j + lane]; const unsigned wx = w.x, wy = w.y; a[0] = bflo(wx); a[1] = bfhi(wx); a[2] = bflo(wy); a[3] = bfhi(wy); }
            else a = ((const f32x4*)((const float*)res_s + (size_t)(m - MP) * DM))[64 * j + lane];
            a = a * ALPHA;
#pragma unroll
            for (int sp = 0; sp < NSPLIT; ++sp) { const unsigned px = p[sp].x, py = p[sp].y; a[0] += bflo(px); a[1] += bfhi(px); a[2] += bflo(py); a[3] += bfhi(py); }
            v[j] = a;
        }
    }
}
__device__ __forceinline__ int ln_row_of(int gw, int NGW, int i) {
    if (NGW == 2048) {
        if (gw < 512) return i == 0 ? MP + gw : (i == 1 ? 7680 + gw : -1);
        return i < 5 ? (gw - 512) + 1536 * i : -1;
    }
    const int m = gw + i * NGW; return m < MT ? m : -1;
}
template <int NSPLIT, bool RB> __device__ __forceinline__ void ln_rows(Ctx& F, const bf16_t* Y, const float* gam, const float* bet, float* o32, bf16_t* o16, const float* part, const void* res_s) {
    const int gw = blockIdx.x * 8 + F.wave(), NGW = F.G_() * 8, lane = F.lane();
    f32x4 nv[8];
    int m = ln_row_of(gw, NGW, 0);
    if (m >= 0) ln_load_row<NSPLIT, RB>(nv, m, lane, Y, part, res_s);
    for (int i = 0; m >= 0; ++i) {
        f32x4 v[8]; float s = 0.f;
#pragma unroll
        for (int j = 0; j < 8; ++j) { v[j] = nv[j]; s += (v[j][0] + v[j][1]) + (v[j][2] + v[j][3]); }
        const int mn = ln_row_of(gw, NGW, i + 1);
        if (mn >= 0) ln_load_row<NSPLIT, RB>(nv, mn, lane, Y, part, res_s);
        const float mean = wave_sum(s) * (1.f / DM); float s2 = 0.f;
#pragma unroll
        for (int j = 0; j < 8; ++j) { v[j] = v[j] - mean; s2 += (v[j][0] * v[j][0] + v[j][1] * v[j][1]) + (v[j][2] * v[j][2] + v[j][3] * v[j][3]); }
        const float rstd = rsqrtf(wave_sum(s2) * (1.f / DM) + LN_EPS);
#pragma unroll
        for (int j = 0; j < 8; ++j) {
            const f32x4 gg = ((const f32x4*)gam)[64 * j + lane], bb = ((const f32x4*)bet)[64 * j + lane];
            const f32x4 o = v[j] * rstd * gg + bb;
            if (o32) __builtin_nontemporal_store(o, (f32x4*)(o32 + (size_t)m * DM) + 64 * j + lane);
            if (o16) { u32x2 w; w.x = pk2(o[0], o[1]); w.y = pk2(o[2], o[3]); __builtin_nontemporal_store(w, (u32x2*)(o16 + (size_t)m * DM + 256 * j + 4 * lane)); }
        }
        m = mn;
    }
}

#define XB_TMO      128
#define XB_XCNT(j)  (256  + 64 * (j))
#define XB_XSUB(j)  (1280 + 64 * (j))
#define XB_XGEN(j)  (2304 + 64 * (j))
#define XB_TOP      3328
#define XB_TOPGEN   3392
#define XCD_BAR_WORDS 3456
#define XB_SPIN_CAP (1u << 18)

__device__ __forceinline__ unsigned xb_ld(unsigned* p)              { return __hip_atomic_load(p, __ATOMIC_RELAXED, __HIP_MEMORY_SCOPE_AGENT); }
__device__ __forceinline__ unsigned xb_add(unsigned* p, unsigned v) { return __hip_atomic_fetch_add(p, v, __ATOMIC_RELAXED, __HIP_MEMORY_SCOPE_AGENT); }
__device__ __forceinline__ unsigned xb_xcc_id() { return (unsigned)__builtin_amdgcn_s_getreg((3 << 11) | 20) & 0xFu; }
#define XB_SPIN(cond, bar) do { unsigned _sp = 0; while (cond) { __builtin_amdgcn_s_sleep(1); \
    if ((++_sp & 255u) == 0u) { if (xb_ld(&(bar)[XB_TMO])) break; if (_sp > XB_SPIN_CAP) { atomicAdd(&(bar)[XB_TMO], 1u); break; } } } } while (0)

struct XcdBarrier {
    unsigned* bar; unsigned x;
    volatile LAS unsigned* st;
};

__device__ __forceinline__ XcdBarrier xcd_barrier_post(unsigned* bar, volatile LAS unsigned* st) {
    XcdBarrier b; b.bar = bar; b.x = xb_xcc_id(); b.st = st;
    if (threadIdx.x == 0) (void)xb_add(&bar[XB_XCNT(b.x)], 1u);
    return b;
}
__device__ __forceinline__ void xcd_barrier_complete(unsigned* bar, unsigned x, unsigned& nloc, unsigned& nx) {
    const unsigned G = gridDim.x * gridDim.y * gridDim.z;
    unsigned sum, cnt, mine, sp = 0u;
    for (;;) {
        sum = 0u; cnt = 0u; mine = 0u;
#pragma unroll
        for (unsigned j = 0; j < 16; ++j) { const unsigned c = xb_ld(&bar[XB_XCNT(j)]); sum += c; cnt += (c > 0u) ? 1u : 0u; mine = (j == x) ? c : mine; }
        if (sum == G) break;
        __builtin_amdgcn_s_sleep(1);
        if ((++sp & 255u) == 0u) { if (xb_ld(&bar[XB_TMO])) break; if (sp > XB_SPIN_CAP) { atomicAdd(&bar[XB_TMO], 1u); break; } }
    }
    nloc = mine > 0u ? mine : 1u; nx = cnt > 0u ? cnt : 1u;
}

__device__ __forceinline__ void xcd_barrier(const XcdBarrier& b) {
    asm volatile("s_waitcnt vmcnt(0)" ::: "memory");
    __syncthreads();
    if (threadIdx.x == 0) {
        unsigned* bar = b.bar;
        __builtin_amdgcn_s_waitcnt(0);
        unsigned nloc = b.st[0], nx = b.st[1];
        if (nloc == 0u) { xcd_barrier_complete(bar, b.x, nloc, nx); b.st[0] = nloc; b.st[1] = nx; }
        const unsigned old = xb_add(&bar[XB_XSUB(b.x)], 1u);
        const unsigned gen = old / nloc;
        if (old + 1u == (gen + 1u) * nloc) {
            __builtin_amdgcn_fence(__ATOMIC_RELEASE, "agent");
            asm volatile("s_waitcnt vmcnt(0)" ::: "memory");
            const unsigned og = xb_add(&bar[XB_TOP], 1u);
            const unsigned tg = og / nx;
            if (og + 1u == (tg + 1u) * nx) xb_add(&bar[XB_TOPGEN], 1u);
            else XB_SPIN(xb_ld(&bar[XB_TOPGEN]) == tg, bar);
            __builtin_amdgcn_fence(__ATOMIC_ACQUIRE, "agent");
            xb_add(&bar[XB_XGEN(b.x)], 1u);
            asm volatile("s_waitcnt vmcnt(0)" ::: "memory");
        } else {
            XB_SPIN(xb_ld(&bar[XB_XGEN(b.x)]) == gen, bar);
            __builtin_amdgcn_fence(__ATOMIC_ACQUIRE, "agent");
            asm volatile("s_waitcnt vmcnt(0)" ::: "memory");
        }
    }
    __syncthreads();
}

struct Args { const float* in[18]; float* out; unsigned char* ws; int ph_lo, ph_hi; };
__global__ void __launch_bounds__(512, 2) mk_fwd(Args args) {
    extern __shared__ __attribute__((aligned(16))) unsigned char lds[];
    cg::grid_group grid = cg::this_grid();
    Ctx F;
    F.kp = (kptr_t)__builtin_amdgcn_kernarg_segment_ptr();
    F.lds = lds;
    const int lo = args.ph_lo, hi = args.ph_hi;
    volatile LAS unsigned* misc = (volatile LAS unsigned*)(lds + LDS_BYTES - 128);
    if (threadIdx.x < 2) misc[threadIdx.x] = 0u;
    __syncthreads();
    XcdBarrier bar = xcd_barrier_post(F.ctl() + 4096, misc);
#define IN(k) (lo <= (k) && (k) < hi)
#define SEAM(k) do { if (IN(k) && IN((k) + 1)) { xcd_barrier(bar); } } while (0)
    LAS unsigned char* ldsl = (LAS unsigned char*)lds;

    if (lo > hi) grid.sync();
    if (IN(0)) p0_prologue(F);
    SEAM(0);
    if (IN(1)) {
        pg8::Gemm g{F.XB(), F.WinT(), MT, NP, DM}; pg8::StaticOrder S; S.init(MT, NP, F.G_(), (int)blockIdx.x, DM);
        pg8::EpiProj E{F.PROJ(), F.out(), OUT_CONVP, OUT_KP, OUT_VP, OUT_CONVS, OUT_KS, OUT_VS};
        pg8::gemm_phase<pg8::EpiProj, pg8::StaticOrder, true, true>(ldsl, g, S, E);
        if (F.G_() == 256 && blockIdx.x >= 184) {
            for (int j = 0; j < 6; ++j) p0_transpose_any(F, NT_EARLY + ((int)blockIdx.x - 184) * 48 + j * 8 + F.wave(), (float*)(F.lds + F.wave() * 16640));
        }
    }
    SEAM(1);
    if (IN(2)) p2_prep(F);
    SEAM(2);
    if (IN(3)) p3_mix(F);
    SEAM(3);
    if (IN(4)) p4_finalize(F);
    SEAM(4);
    if (IN(5)) {
        pg8::Gemm g{F.MIX(), F.WoutT(), MT, DM, DM}; pg8::SplitOrder S; S.init(MP, MT, DM, DM, NSPLIT1, F.G_(), (int)blockIdx.x);
        pg8::EpiRes<true> E{F.XB(), F.XB(), MT, F.Y1(), DM, ALPHA, F.PART1()};
        pg8::gemm_phase<pg8::EpiRes<true>, pg8::SplitOrder, true, true>(ldsl, g, S, E);
    }
    SEAM(5);
    if (IN(6)) ln_rows<NSPLIT1, false>(F, F.Y1(), F.ln1_g(), F.ln1_b(), nullptr, F.XB(), F.PART1(), F.x_sample());
    SEAM(6);
    if (IN(7)) {
        pg8::Gemm g{F.XB(), F.WupT(), MT, FF, DM}; pg8::StaticOrder S; S.init(MT, FF, F.G_(), (int)blockIdx.x, DM);
        pg8::EpiUp E{F.HB(), FF};
        pg8::gemm_phase<pg8::EpiUp, pg8::StaticOrder, true, true>(ldsl, g, S, E);
        if (F.G_() == 256 && blockIdx.x >= 64) {
            for (int idx = ((int)blockIdx.x - 64) * 8 + F.wave(); idx < I_DN; idx += 192 * 8) p0_transpose_any(F, NT_EARLY + I_OUT + I_UP + idx, (float*)(F.lds + F.wave() * 16640));
        }
    }
    SEAM(7);
    if (IN(8)) {
        pg8::Gemm g{F.HB(), F.WdnT(), MT, DM, FF}; pg8::SplitOrder S; S.init(MP, MT, DM, FF, NSPLIT2, F.G_(), (int)blockIdx.x);
        pg8::EpiRes<true> E{F.XB(), F.XB(), MT, F.Y2(), DM, ALPHA, F.PART2()};
        pg8::gemm_phase<pg8::EpiRes<true>, pg8::SplitOrder, true, true>(ldsl, g, S, E);
    }
    SEAM(8);
    if (IN(9)) ln_rows<NSPLIT2, true>(F, F.Y2(), F.ln2_g(), F.ln2_b(), F.out() + OUT_YP, nullptr, F.PART2(), F.XB() + (size_t)MP * DM);
#undef IN
#undef SEAM
}

extern "C" void kernel_launch(void* const* d_in, const int* in_sizes, int n_in, void* d_out, int out_size, void* d_ws, size_t ws_size, hipStream_t stream) {
    static int grid = 0;
    if (grid == 0) {
        if (n_in != 18 || (size_t)out_size != OUT_END || ws_size < WS_END) { fprintf(stderr, "kernel_launch: unexpected shapes: n_in %d out %d ws %zu (need %zu)\n", n_in, out_size, ws_size, (size_t)WS_END); grid = -1; return; }
        int dev = 0, cus = 0, per_cu = 0;
        hipGetDevice(&dev); hipDeviceGetAttribute(&cus, hipDeviceAttributeMultiprocessorCount, dev);
        if (hipFuncSetAttribute((const void*)mk_fwd, hipFuncAttributeMaxDynamicSharedMemorySize, LDS_BYTES) != hipSuccess) { fprintf(stderr, "kernel_launch: hipFuncSetAttribute failed\n"); grid = -1; return; }
        if (hipOccupancyMaxActiveBlocksPerMultiprocessor(&per_cu, (const void*)mk_fwd, 512, LDS_BYTES) != hipSuccess || per_cu < 1) { fprintf(stderr, "kernel_launch: occupancy query says %d\n", per_cu); per_cu = 1; }
        (void)hipGetLastError();
        grid = cus * (per_cu > 1 ? 1 : per_cu);
        if (grid <= 0) grid = 256;
    }
    if (grid < 0) return;
    hipMemsetAsync((char*)d_ws + WS_CTL, 0, 65536, stream);
    Args a{};
    for (int i = 0; i < 18; ++i) a.in[i] = (const float*)d_in[i];
    a.out = (float*)d_out; a.ws = (unsigned char*)d_ws;
    void* kargs[] = {&a};
#if MK_N_LAUNCHES == 1
    a.ph_lo = 0; a.ph_hi = NPHASE;
    hipError_t e = hipLaunchCooperativeKernel((const void*)mk_fwd, dim3(grid), dim3(512), kargs, LDS_BYTES, stream);
    if (e != hipSuccess) fprintf(stderr, "cooperative launch failed: %s (grid %d)\n", hipGetErrorString(e), grid);
#else
    for (int p = 0; p < NPHASE; ++p) {
        a.ph_lo = p; a.ph_hi = p + 1;
        hipError_t e = hipLaunchCooperativeKernel((const void*)mk_fwd, dim3(grid), dim3(512), kargs, LDS_BYTES, stream);
        if (e != hipSuccess) { fprintf(stderr, "cooperative launch %d failed: %s (grid %d)\n", p, hipGetErrorString(e), grid); break; }
    }
#endif
}
```
